# Optimizing an MI355X kernel written in HIP

```python
import math
import jax, jax.numpy as jnp
from jax import lax
import numpy as np

D_MODEL = 1024
BATCH = 32
SEQ = 2048
DEPTH = 2
DEC_BATCH = 16
DEC_SEQ = 2048
PAST_LEN = 128

M_HEADS = 4
D_M = D_MODEL
M_DH = D_M // M_HEADS
M_CHUNK = 64
CONV_K = 5
FORGET_BIAS = 3.0
A_HEADS = 8
A_KV_HEADS = 2
A_DH = 64
D_A = A_HEADS * A_DH
A_KV = A_KV_HEADS * A_DH
WINDOW = 128
A_BLOCK = WINDOW
D_C = D_MODEL // 2
C_GROUPS = 4
C_CHUNK = 128
D_FF = 4 * D_MODEL
N_BRANCH = 3
ALPHA = (2 * DEPTH) ** 0.25
BETA = (8 * DEPTH) ** -0.25
LN_EPS = 1e-5

OFF_MX = 0
OFF_MZ = OFF_MX + D_M
OFF_MG = OFF_MZ + D_M
OFF_AQ = OFF_MG + 4 * M_HEADS
OFF_AK = OFF_AQ + D_A
OFF_AV = OFF_AK + A_KV
OFF_C = OFF_AV + A_KV
OFF_G = OFF_C + 2 * D_C
N_IN = OFF_G + N_BRANCH * D_MODEL

kernel_name = 'hybrid_bidir_mlstm_swa_sgu_encoder'


def layer_norm(x, w, b):
    xf = x.astype(jnp.float32)
    mu = jnp.mean(xf, -1, keepdims=True)
    var = jnp.mean(jnp.square(xf - mu), -1, keepdims=True)
    return ((xf - mu) * lax.rsqrt(var + LN_EPS)).astype(x.dtype) * w + b


def centred_dwconv(x, w, b):
    pad = CONV_K // 2
    y = lax.conv_general_dilated(x, w[:, None, :], window_strides=(1,), padding=[(pad, pad)],
                                 dimension_numbers=('NWC', 'WIO', 'NWC'),
                                 feature_group_count=x.shape[-1])
    return y + b


def mlstm_scan(q, k, v, ig, fg):
    B, H, S, dh = q.shape
    L = M_CHUNK
    nC = S // L
    logf = jax.nn.log_sigmoid(fg)

    def to_chunks(t):
        return jnp.moveaxis(t.reshape(B, H, nC, L, *t.shape[3:]), 2, 0)

    xs = (to_chunks(q), to_chunks(k), to_chunks(v), to_chunks(ig), to_chunks(logf))
    lower = jnp.tril(jnp.ones((L, L), dtype=bool))

    def step(carry, inp):
        C, n, m = carry
        qj, kj, vj, ij, fj = inp
        a = jnp.cumsum(fj, axis=-1)
        A = a[..., -1]
        Dm = a[..., :, None] - a[..., None, :] + ij[..., None, :]
        Dm = jnp.where(lower, Dm, -jnp.inf)
        inter = a + m[..., None]
        m_row = jnp.maximum(inter, jnp.max(Dm, -1))
        w_intra = jnp.exp(Dm - m_row[..., None])
        w_inter = jnp.exp(inter - m_row)
        s = jnp.einsum('bhld,bhsd->bhls', qj, kj) * w_intra
        num = (jnp.einsum('bhls,bhsd->bhld', s, vj)
               + w_inter[..., None] * jnp.einsum('bhvk,bhlk->bhlv', C, qj))
        den = jnp.sum(s, -1) + w_inter * jnp.einsum('bhk,bhlk->bhl', n, qj)
        h = num / jnp.maximum(jnp.abs(den), jnp.exp(-m_row))[..., None]
        g = A[..., None] - a + ij
        m_new = jnp.maximum(A + m, jnp.max(g, -1))
        wg = jnp.exp(g - m_new[..., None])
        decay = jnp.exp(A + m - m_new)
        C_new = decay[..., None, None] * C + jnp.einsum('bhs,bhsv,bhsk->bhvk', wg, vj, kj)
        n_new = decay[..., None] * n + jnp.einsum('bhs,bhsk->bhk', wg, kj)
        return (C_new, n_new, m_new), h

    init = (jnp.zeros((B, H, dh, dh), jnp.float32), jnp.zeros((B, H, dh), jnp.float32),
            jnp.zeros((B, H), jnp.float32))
    _, hc = lax.scan(step, init, xs)
    return jnp.moveaxis(hc, 0, 2).reshape(B, H, S, dh)


def mlstm_branch(xm, zm, gates, conv_w, conv_b, wq, wk, wv, norm_w):
    B, S, _ = xm.shape
    xc = jax.nn.silu(centred_dwconv(xm, conv_w, conv_b))
    heads = lambda t: t.reshape(B, S, M_HEADS, M_DH)
    f32 = jnp.float32
    q = jnp.einsum('bshd,hde->bhse', heads(xc), wq).astype(f32)
    k = (jnp.einsum('bshd,hde->bhse', heads(xc), wk) * (M_DH ** -0.5)).astype(f32)
    v = jnp.einsum('bshd,hde->bhse', heads(xm), wv).astype(f32)
    g = jnp.moveaxis(gates.astype(f32).reshape(B, S, 4, M_HEADS), 1, -1)
    h_fwd = mlstm_scan(q, k, v, g[:, 0], g[:, 1])
    rev = lambda t: jnp.flip(t, axis=2)
    h_bwd = rev(mlstm_scan(rev(q), rev(k), rev(v), rev(g[:, 2]), rev(g[:, 3])))
    h = h_fwd + h_bwd
    mu = jnp.mean(h, -1, keepdims=True)
    var = jnp.mean(jnp.square(h - mu), -1, keepdims=True)
    hn = (h - mu) * lax.rsqrt(var + LN_EPS)
    hn = jnp.moveaxis(hn, 1, 2).reshape(B, S, D_M).astype(xm.dtype) * norm_w
    return hn * jax.nn.sigmoid(zm)


def window_attention(q, k, v, sink):
    B, S = q.shape[0], q.shape[1]
    Q = A_BLOCK
    nB = S // Q
    G, R = A_KV_HEADS, A_HEADS // A_KV_HEADS
    f32 = jnp.float32
    qb = q.reshape(B, nB, Q, G, R, A_DH)
    pad = ((0, 0), (Q, Q), (0, 0), (0, 0))
    kp = jnp.pad(k, pad)
    vp = jnp.pad(v, pad)
    idx = jnp.arange(nB)[:, None] * Q + jnp.arange(3 * Q)[None, :]
    kb = kp[:, idx]
    vb = vp[:, idx]
    s = jnp.einsum('bnqgrd,bnkgd->bgrnqk', qb, kb).astype(f32) * (A_DH ** -0.5)
    qpos = jnp.arange(S).reshape(nB, Q)
    kpos = idx - Q
    dist_i = jnp.abs(qpos[:, :, None] - kpos[:, None, :])
    valid = (dist_i <= WINDOW) & (kpos[:, None, :] >= 0) & (kpos[:, None, :] < S)
    slopes = jnp.exp2(-8.0 * (jnp.arange(A_HEADS, dtype=f32) + 1.0) / A_HEADS).reshape(G, R)
    s = s - slopes[:, :, None, None, None] * dist_i.astype(f32)
    s = jnp.where(valid, s, -jnp.inf)
    sink_f = sink.astype(f32).reshape(G, R)[:, :, None, None, None]
    mx = jnp.maximum(jnp.max(s, -1, keepdims=True), sink_f)
    p = jnp.exp(s - mx)
    p = p / (jnp.sum(p, -1, keepdims=True) + jnp.exp(sink_f - mx))
    o = jnp.einsum('bgrnqk,bnkgd->bnqgrd', p.astype(v.dtype), vb)
    return o.reshape(B, S, D_A)


def spatial_gating(uv, ln_w, ln_b, ws, bs):
    B, S, _ = uv.shape
    uv = jax.nn.gelu(uv)
    u = uv[..., :D_C]
    v = layer_norm(uv[..., D_C:], ln_w, ln_b)
    nC = S // C_CHUNK
    vg = v.reshape(B, nC, C_CHUNK, C_GROUPS, D_C // C_GROUPS)
    vs = jnp.einsum('gts,bnsgc->bntgc', ws, vg) + bs.T[:, :, None]
    return u * vs.reshape(B, S, D_C)


def token_mixers(h, p, l):
    B, S, _ = h.shape
    proj = h @ p['w_in'][l] + p['b_in'][l]
    y_m = mlstm_branch(proj[..., OFF_MX:OFF_MZ], proj[..., OFF_MZ:OFF_MG], proj[..., OFF_MG:OFF_AQ],
                       p['m_conv_w'][l], p['m_conv_b'][l], p['m_wq'][l], p['m_wk'][l],
                       p['m_wv'][l], p['m_norm_w'][l])
    q = proj[..., OFF_AQ:OFF_AK].reshape(B, S, A_HEADS, A_DH)
    k = proj[..., OFF_AK:OFF_AV].reshape(B, S, A_KV_HEADS, A_DH)
    v = proj[..., OFF_AV:OFF_C].reshape(B, S, A_KV_HEADS, A_DH)
    y_a = window_attention(q, k, v, p['a_sink'][l])
    y_c = spatial_gating(proj[..., OFF_C:OFF_G], p['c_ln_w'][l], p['c_ln_b'][l],
                         p['c_ws'][l], p['c_bs'][l])
    g = jax.nn.sigmoid(proj[..., OFF_G:]).reshape(B, S, N_BRANCH, D_MODEL)
    merged = (g[..., 0, :] * (y_m @ p['p_m'][l])
              + g[..., 1, :] * (y_a @ p['p_a'][l])
              + g[..., 2, :] * (y_c @ p['p_c'][l]))
    return merged @ p['w_out'][l]


def encoder_trunk(x, c, p):
    for l in range(DEPTH):
        mod = jax.nn.silu(c) @ p['ada_w'][l] + p['ada_b'][l]
        sh1, sc1, g1, sh2, sc2, g2 = jnp.split(mod[:, None, :], 6, axis=-1)
        mix = token_mixers(x * (1 + sc1) + sh1, p, l)
        x = layer_norm(ALPHA * x + (1 + g1) * mix, p['ln1_w'][l], p['ln1_b'][l])
        hid = jnp.square(jax.nn.relu((x * (1 + sc2) + sh2) @ p['mlp_w1'][l] + p['mlp_b1'][l]))
        ff = hid @ p['mlp_w2'][l] + p['mlp_b2'][l]
        x = layer_norm(ALPHA * x + (1 + g2) * ff, p['ln2_w'][l], p['ln2_b'][l])
    return x


def setup_inputs(seed: int = 0) -> dict:
    key = jax.random.key(seed)
    ks = iter(jax.random.split(key, 40))
    nrm = lambda shape, scale: jax.random.normal(next(ks), shape, jnp.float32) * scale
    L = DEPTH
    f_cols = np.concatenate([OFF_MG + M_HEADS + np.arange(M_HEADS),
                             OFF_MG + 3 * M_HEADS + np.arange(M_HEADS)])
    b_in = nrm((L, N_IN), 0.02).at[:, f_cols].add(FORGET_BIAS)
    return {
        'x_prompt': nrm((BATCH, SEQ, D_MODEL), 1.0),
        'x_sample': nrm((DEC_BATCH, DEC_SEQ, D_MODEL), 1.0),
        'c_prompt': nrm((BATCH, D_MODEL), 1.0),
        'c_sample': nrm((DEC_BATCH, D_MODEL), 1.0),
        'ada_w': nrm((L, D_MODEL, 6 * D_MODEL), 0.2 * D_MODEL ** -0.5),
        'ada_b': nrm((L, 6 * D_MODEL), 0.02),
        'w_in': nrm((L, D_MODEL, N_IN), D_MODEL ** -0.5),
        'b_in': b_in,
        'm_conv_w': nrm((L, CONV_K, D_M), CONV_K ** -0.5),
        'm_conv_b': nrm((L, D_M), 0.02),
        'm_wq': nrm((L, M_HEADS, M_DH, M_DH), M_DH ** -0.5),
        'm_wk': nrm((L, M_HEADS, M_DH, M_DH), M_DH ** -0.5),
        'm_wv': nrm((L, M_HEADS, M_DH, M_DH), M_DH ** -0.5),
        'm_norm_w': 1.0 + nrm((L, D_M), 0.02),
        'a_sink': nrm((L, A_HEADS), 0.5),
        'c_ln_w': 1.0 + nrm((L, D_C), 0.02),
        'c_ln_b': nrm((L, D_C), 0.02),
        'c_ws': nrm((L, C_GROUPS, C_CHUNK, C_CHUNK), C_CHUNK ** -0.5),
        'c_bs': 1.0 + nrm((L, C_GROUPS, C_CHUNK), 0.02),
        'p_m': nrm((L, D_M, D_MODEL), BETA * D_M ** -0.5),
        'p_a': nrm((L, D_A, D_MODEL), BETA * D_A ** -0.5),
        'p_c': nrm((L, D_C, D_MODEL), BETA * D_C ** -0.5),
        'w_out': nrm((L, D_MODEL, D_MODEL), BETA * D_MODEL ** -0.5),
        'ln1_w': 1.0 + nrm((L, D_MODEL), 0.02),
        'ln1_b': nrm((L, D_MODEL), 0.02),
        'mlp_w1': nrm((L, D_MODEL, D_FF), D_MODEL ** -0.5),
        'mlp_b1': nrm((L, D_FF), 0.02),
        'mlp_w2': nrm((L, D_FF, D_MODEL), BETA * D_FF ** -0.5),
        'mlp_b2': nrm((L, D_MODEL), 0.02),
        'ln2_w': 1.0 + nrm((L, D_MODEL), 0.02),
        'ln2_b': nrm((L, D_MODEL), 0.02),
    }


def reference(x_prompt, x_sample, c_prompt, c_sample, ada_w, ada_b, w_in, b_in, m_conv_w, m_conv_b,
              m_wq, m_wk, m_wv, m_norm_w, a_sink, c_ln_w, c_ln_b, c_ws, c_bs, p_m, p_a, p_c, w_out,
              ln1_w, ln1_b, mlp_w1, mlp_b1, mlp_w2, mlp_b2, ln2_w, ln2_b):
    params = dict(ada_w=ada_w, ada_b=ada_b, w_in=w_in, b_in=b_in, m_conv_w=m_conv_w,
                  m_conv_b=m_conv_b, m_wq=m_wq, m_wk=m_wk, m_wv=m_wv, m_norm_w=m_norm_w,
                  a_sink=a_sink, c_ln_w=c_ln_w, c_ln_b=c_ln_b, c_ws=c_ws, c_bs=c_bs,
                  p_m=p_m, p_a=p_a, p_c=p_c, w_out=w_out, ln1_w=ln1_w, ln1_b=ln1_b,
                  mlp_w1=mlp_w1, mlp_b1=mlp_b1, mlp_w2=mlp_w2, mlp_b2=mlp_b2,
                  ln2_w=ln2_w, ln2_b=ln2_b)
    y_prompt = encoder_trunk(x_prompt, c_prompt, params)
    y_sample = encoder_trunk(x_sample, c_sample, params)
    return (y_prompt, y_sample)
```

```cpp
#include <hip/hip_runtime.h>
#include <hip/hip_cooperative_groups.h>
#include <cstdio>
namespace cg = cooperative_groups;

typedef unsigned short bf16_t;
using bf16x8 = __attribute__((ext_vector_type(8))) short;
using f32x16 = __attribute__((ext_vector_type(16))) float;
#define DI __device__ __forceinline__
#define MFMA(a, b, c) __builtin_amdgcn_mfma_f32_32x32x16_bf16((a), (b), (c), 0, 0, 0)

#ifndef MULTI_LAUNCH
#define MULTI_LAUNCH 0
#endif
#ifndef REPEAT_MASK
#define REPEAT_MASK 0
#ifndef REPEAT_ATT
#define REPEAT_ATT 0
#endif
#ifndef REPEAT_SCAN
#define REPEAT_SCAN 0
#endif
#endif
#ifndef PROBE_EPI2
#define PROBE_EPI2 0
#endif
#ifndef EXTRA_SYNC
#define EXTRA_SYNC 0
#endif

constexpr int NT = 512;
constexpr int SEQ = 2048, D = 1024;
constexpr int GSEQ = 16;
constexpr int TG = GSEQ * SEQ;
constexpr int NGROUP = 3;
constexpr int NSEQ_ALL = 48;
constexpr int DEPTH = 2;
constexpr int N_IN = 6928, N_INP = 7168;
constexpr int LDP = 6912;
constexpr int P_XM = 0, P_Z = 1024, P_AQ = 2048, P_AK = 2560, P_AV = 2688, P_U = 2816, P_V = 3328, P_G = 3840;
constexpr float ALPHA = 1.4142135623730951f;
constexpr float LN_EPS = 1e-5f;

enum { I_XP = 0, I_XS, I_CP, I_CS, I_ADAW, I_ADAB, I_WIN, I_BIN, I_CONVW, I_CONVB, I_WQ, I_WK, I_WV, I_NORMW, I_SINK,
       I_CLNW, I_CLNB, I_CWS, I_CBS, I_PM, I_PA, I_PC, I_WOUT, I_LN1W, I_LN1B, I_W1, I_B1, I_W2, I_B2, I_LN2W, I_LN2B };

constexpr size_t W_IN = 0, W_QKV = 7340032, W_PM = 8126464, W_PA = 9175040  , W_PC = W_PA + 512, W_OUT = 10223616,
                 W_1 = 11272192, W_2 = 15466496, W_LAYER = 19660800;
constexpr size_t MiB = 1u << 20;
constexpr size_t OFF_W = 0;
constexpr size_t OFF_MOD = 80 * MiB;
constexpr size_t OFF_BINP = 83 * MiB;
constexpr size_t OFF_R0 = 84 * MiB;
constexpr size_t OFF_R2 = 148 * MiB;
constexpr size_t OFF_R1 = 212 * MiB;
constexpr size_t OFF_R3 = 644 * MiB;
constexpr size_t OFF_R5 = 900 * MiB;
constexpr size_t OFF_GATES = 964 * MiB;
constexpr size_t OFF_GPRE = 966 * MiB;
constexpr size_t OFF_BAR = 970 * MiB;
constexpr size_t WS_END = 971 * MiB;

constexpr int LDS_WORK = 150 * 1024;
constexpr int LDS_BYTES = LDS_WORK + 64;

struct Params {
  const float* in[31];
  float* out;
  unsigned char* ws;
  int step_lo, step_hi;
};

typedef __bf16 bf2_t __attribute__((ext_vector_type(2)));
typedef float f2_t __attribute__((ext_vector_type(2)));
DI bf16_t f2bf(float x) { return __builtin_bit_cast(unsigned short, (__bf16)x); }
DI float bf2f(bf16_t b) { return __uint_as_float(((unsigned)b) << 16); }
DI unsigned pack2(float a, float b) { f2_t v = {a, b}; return __builtin_bit_cast(unsigned, __builtin_convertvector(v, bf2_t)); }
DI float lo2f(unsigned u) { return __uint_as_float(u << 16); }
DI float hi2f(unsigned u) { return __uint_as_float(u & 0xffff0000u); }
DI int crow(int e, int h) { return (e & 3) + 8 * (e >> 2) + 4 * h; }
DI float sigmoidf_(float x) { return __builtin_amdgcn_rcpf(1.f + __builtin_amdgcn_exp2f(-1.4426950408889634f * x)); }
DI float gelu_tanh(float x) {
  const float u2 = 1.5957691216057308f * (x + 0.044715f * x * x * x);
  return x * __builtin_amdgcn_rcpf(1.f + __builtin_amdgcn_exp2f(-1.4426950408889634f * u2));
}
template <int M> DI float sx(float v) { return __int_as_float(__builtin_amdgcn_ds_swizzle(__float_as_int(v), (M << 10) | 0x1F)); }
DI float bperm(int src_lane, float v) { return __int_as_float(__builtin_amdgcn_ds_bpermute(src_lane << 2, __float_as_int(v))); }
DI float wsum(float v, int lane) { v += sx<1>(v); v += sx<2>(v); v += sx<4>(v); v += sx<8>(v); v += sx<16>(v); v += bperm(lane ^ 32, v); return v; }

#define LAS __attribute__((address_space(3)))
using f32x4 = __attribute__((ext_vector_type(4))) float;
constexpr int GBK = 64, GHALF = 128, HTB = GHALF * GBK * 2;
DI int lds_byte(int r, int c) { const int st = (r >> 4) * 2 + (c >> 5), rr = r & 15, cc = c & 31, ob = rr * 64 + cc * 2; return st * 1024 + (ob ^ (((ob >> 9) & 1) << 5)); }
DI void stage_rc(int b, int& R, int& C) { const int st = b / 1024, sb = b % 1024, swz = sb ^ (((sb >> 9) & 1) << 5); R = (st >> 1) * 16 + swz / 64; C = (st & 1) * 32 + (swz % 64) / 2; }
DI int perm32(int rho) { const int n = rho >> 4, i = rho & 15; return 8 * (i >> 2) + 4 * n + (i & 3); }
struct GUnit { const char* A; const char* B; int nt, pm, pn, tag; };
typedef f32x4 GAcc[2][2][4][2];

DI void static_unit(int L, int nM, int nN, int& pm, int& pn) {
  const int nwg = nM * nN;
  int wgid = L; { const int q = nwg / 8, r = nwg % 8, xcd = wgid % 8, off = wgid / 8; wgid = (xcd < r ? xcd * (q + 1) : r * (q + 1) + (xcd - r) * q) + off; }
  const int nig = 8 * nN, gid = wgid / nig, fm = gid * 8, gsz = (nM - fm) < 8 ? (nM - fm) : 8;
  pm = fm + ((wgid % nig) % gsz); pn = (wgid % nig) / gsz;
}

template <class Sched, class Epi>
DI void gemm_phase8(bf16_t* lds_generic, int lda, int ldb, const Sched& S, const Epi& E, int tid) {
  LAS unsigned char* lds = (LAS unsigned char*)lds_generic;
  const int wid = __builtin_amdgcn_readfirstlane(tid >> 6), lane = tid & 63, wr = wid >> 2, wc = wid & 3, fr = lane & 15, fq = lane >> 4;
  unsigned voffA[2], voffB[2];
#pragma unroll
  for (int i = 0; i < 2; ++i) { int R, C; stage_rc(tid * 16 + i * 8192, R, C); const int Rb = (R & ~31) + perm32(R & 31);
    voffA[i] = (unsigned)(R * lda + C) * 2u; voffB[i] = (unsigned)(Rb * ldb + C) * 2u; }
  const size_t kstep = (size_t)(GBK * 2);
  const size_t hstepA = (size_t)GHALF * lda * 2, hstepB = (size_t)GHALF * ldb * 2;
  const unsigned ldsw = (unsigned)wid * 1024u;
  const int aoff = lds_byte(wr * 64 + fr, fq * 8), boff = lds_byte(wc * 32 + fr, fq * 8);
#define PG8_SA(b, h) (((b) * 2 + (h)) * HTB)
#define PG8_SB(b, h) ((4 + (b) * 2 + (h)) * HTB)
#define PG8_STAGE(bufoff, gbase, voff) do { _Pragma("unroll") for (int _i = 0; _i < 2; ++_i) \
    __builtin_amdgcn_global_load_lds((const unsigned*)((const char*)(gbase) + (voff)[_i]), (LAS unsigned*)(lds + (bufoff) + ldsw + _i * 8192), 16, 0, 0); } while (0)
#define PG8_LDA(dst, b, h) do { _Pragma("unroll") for (int m = 0; m < 4; ++m) _Pragma("unroll") for (int k = 0; k < 2; ++k) dst[m][k] = *(const LAS bf16x8*)(lds + PG8_SA(b, h) + aoff + m * 2048 + k * 1024); } while (0)
#define PG8_LDB(dst, b, h) do { _Pragma("unroll") for (int n = 0; n < 2; ++n) _Pragma("unroll") for (int k = 0; k < 2; ++k) dst[n][k] = *(const LAS bf16x8*)(lds + PG8_SB(b, h) + boff + n * 2048 + k * 1024); } while (0)
#define PG8_MMA(ai, bj, At, Bt) do { __builtin_amdgcn_s_setprio(1); _Pragma("unroll") for (int m = 0; m < 4; ++m) _Pragma("unroll") for (int n = 0; n < 2; ++n) _Pragma("unroll") for (int k = 0; k < 2; ++k) \
    acc[ai][bj][m][n] = __builtin_amdgcn_mfma_f32_16x16x32_bf16(Bt[n][k], At[m][k], acc[ai][bj][m][n], 0, 0, 0); __builtin_amdgcn_s_setprio(0); } while (0)
#define PG8_WAIT_V(n) asm volatile("s_waitcnt vmcnt(" #n ")" ::: "memory")
#define PG8_WAIT_L(n) asm volatile("s_waitcnt lgkmcnt(" #n ")" ::: "memory")
#define PG8_BAR __builtin_amdgcn_s_barrier()
#define PG8_SCHED __builtin_amdgcn_sched_barrier(0)
  GUnit cur, nxt; int ui = 0;
  if (!S(0, cur)) return;
  GAcc acc;
#pragma unroll
  for (int a = 0; a < 2; ++a)
#pragma unroll
    for (int b = 0; b < 2; ++b)
#pragma unroll
      for (int m = 0; m < 4; ++m)
#pragma unroll
        for (int n = 0; n < 2; ++n) acc[a][b][m][n] = (f32x4){0.f, 0.f, 0.f, 0.f};
  bf16x8 At[4][2], B0[2][2], B1[2][2];
  const char* cA = cur.A; const char* cB = cur.B;
  PG8_STAGE(PG8_SB(0, 0), cB, voffB); PG8_STAGE(PG8_SA(0, 0), cA, voffA); PG8_STAGE(PG8_SB(0, 1), cB + hstepB, voffB); PG8_STAGE(PG8_SA(0, 1), cA + hstepA, voffA);
  if (wr == 1) PG8_BAR;
  PG8_WAIT_V(4); PG8_BAR;
  PG8_STAGE(PG8_SB(1, 0), cB + kstep, voffB); PG8_STAGE(PG8_SA(1, 0), cA + kstep, voffA); PG8_STAGE(PG8_SB(1, 1), cB + hstepB + kstep, voffB);
  PG8_WAIT_V(6); PG8_BAR;
  for (;;) {
    const bool has_next = S(ui + 1, nxt);
    const char* nA = has_next ? nxt.A : cA; const char* nB = has_next ? nxt.B : cB;
    const int nt = cur.nt;
#pragma unroll 1
    for (int t = 0; t < nt; t += 2) {
      const bool last = (t == nt - 2);
      const char* a1 = cA + (size_t)(t + 1) * kstep;
      const char* a2 = last ? nA : cA + (size_t)(t + 2) * kstep; const char* b2 = last ? nB : cB + (size_t)(t + 2) * kstep;
      const char* a3 = a2 + kstep; const char* b3 = b2 + kstep;
      PG8_LDB(B0, 0, 0); PG8_SCHED; PG8_LDA(At, 0, 0); PG8_STAGE(PG8_SA(1, 1), a1 + hstepA, voffA);
      PG8_WAIT_L(8); PG8_BAR; PG8_WAIT_L(0); PG8_MMA(0, 0, At, B0); PG8_BAR; PG8_SCHED;
      PG8_LDB(B1, 0, 1); PG8_STAGE(PG8_SB(0, 0), b2, voffB);
      PG8_BAR; PG8_WAIT_L(0); PG8_MMA(0, 1, At, B1); PG8_BAR;
      PG8_LDA(At, 0, 1); PG8_STAGE(PG8_SA(0, 0), a2, voffA);
      PG8_BAR; PG8_WAIT_L(0); PG8_MMA(1, 0, At, B0); PG8_BAR; PG8_SCHED;
      PG8_STAGE(PG8_SB(0, 1), b2 + hstepB, voffB);
      PG8_WAIT_V(6); PG8_BAR; PG8_MMA(1, 1, At, B1); PG8_BAR;
      PG8_LDB(B0, 1, 0); PG8_SCHED; PG8_LDA(At, 1, 0); PG8_STAGE(PG8_SA(0, 1), a2 + hstepA, voffA);
      PG8_WAIT_L(8); PG8_BAR; PG8_WAIT_L(0); PG8_MMA(0, 0, At, B0); PG8_BAR; PG8_SCHED;
      PG8_LDB(B1, 1, 1); PG8_STAGE(PG8_SB(1, 0), b3, voffB);
      PG8_BAR; PG8_WAIT_L(0); PG8_MMA(0, 1, At, B1); PG8_BAR;
      PG8_LDA(At, 1, 1); PG8_STAGE(PG8_SA(1, 0), a3, voffA);
      PG8_BAR; PG8_WAIT_L(0); PG8_MMA(1, 0, At, B0); PG8_BAR; PG8_SCHED;
      PG8_STAGE(PG8_SB(1, 1), b3 + hstepB, voffB);
      PG8_WAIT_V(6); PG8_BAR; PG8_MMA(1, 1, At, B1); PG8_BAR;
    }
    const bool keep = E(acc, cur, wr, wc, fr, fq);
#if PROBE_EPI2
    if (!keep) E(acc, cur, wr, wc, fr, fq);
#endif
    if (!has_next) break;
    if (!keep)
#pragma unroll
    for (int a = 0; a < 2; ++a)
#pragma unroll
      for (int b = 0; b < 2; ++b)
#pragma unroll
        for (int m = 0; m < 4; ++m)
#pragma unroll
          for (int n = 0; n < 2; ++n) acc[a][b][m][n] = (f32x4){0.f, 0.f, 0.f, 0.f};
    cur = nxt; cA = nA; cB = nB; ++ui;
  }
  PG8_WAIT_V(0);
  if (wr == 0) PG8_BAR;
  PG8_BAR;
#undef PG8_SA
#undef PG8_SB
#undef PG8_STAGE
#undef PG8_LDA
#undef PG8_LDB
#undef PG8_MMA
#undef PG8_WAIT_V
#undef PG8_WAIT_L
#undef PG8_BAR
#undef PG8_SCHED
}

template <class F> DI void for_rows8(const GAcc& acc, int wr, int wc, int fr, int fq, F f) {
#pragma unroll
  for (int ai = 0; ai < 2; ++ai)
#pragma unroll
    for (int m = 0; m < 4; ++m)
#pragma unroll
      for (int bj = 0; bj < 2; ++bj) f(ai * 128 + wr * 64 + m * 16 + fr, bj * 128 + wc * 32 + 8 * fq, acc[ai][bj][m][0], acc[ai][bj][m][1]);
}
template <class F> DI void for_rows8b(const GAcc& acc, int wr, int wc, int fr, int fq, F f) {
#pragma unroll
  for (int ai = 0; ai < 2; ++ai)
#pragma unroll
    for (int m = 0; m < 4; ++m)
#pragma unroll
      for (int bj = 0; bj < 2; ++bj) f(ai * 128 + wr * 64 + m * 16 + fr, bj * 128 + wc * 32 + 8 * fq, bj, acc[ai][bj][m][0], acc[ai][bj][m][1]);
}
struct ColVec { f32x4 v[2][2]; };
DI ColVec load_cols(const float* p, int wc, int fq) {
  ColVec c;
#pragma unroll
  for (int bj = 0; bj < 2; ++bj)
#pragma unroll
    for (int n = 0; n < 2; ++n) c.v[bj][n] = *(const f32x4*)(p + bj * 128 + wc * 32 + 8 * fq + 4 * n);
  return c;
}
DI uint4 pack8(f32x4 a, f32x4 b) { uint4 o; o.x = pack2(a[0], a[1]); o.y = pack2(a[2], a[3]); o.z = pack2(b[0], b[1]); o.w = pack2(b[2], b[3]); return o; }

struct Ctx {
  const Params* p;
  int g, l;
  int tid, bid, nb;
  unsigned char* wsp;
  bf16_t* lds;
  DI const float* in(int i) const { int ii = i; asm volatile("" : "+s"(ii)); return p->in[ii]; }
  DI unsigned char* ws() const { return wsp; }
  DI const bf16_t* W(size_t off) const { return (const bf16_t*)(wsp + OFF_W) + (size_t)l * W_LAYER + off; }
  DI const float* mod(int which, int seq_local) const {
    return (const float*)(wsp + OFF_MOD) + ((size_t)(l * NSEQ_ALL + g * GSEQ + seq_local)) * 6144 + which * 1024;
  }
  DI const float* xin() const {
    if (l == 0) return (g < 2) ? in(I_XP) + (size_t)g * TG * D : in(I_XS);
    return p->out + (size_t)g * TG * D;
  }
  DI float* xout() const { return p->out + (size_t)g * TG * D; }
};

DI void transpose_tile(const float* __restrict__ src, int ldsrc, int k0, int srccol0, int nvalid, bf16_t* __restrict__ dst, int lddst,
                       int n0, float scale, float* lds, int tid) {
  {
    const int n = tid & 63, kk = tid >> 6;
#pragma unroll
    for (int i = 0; i < 8; ++i) {
      const int k = kk + 8 * i;
      lds[k * 65 + n] = (n < nvalid) ? src[(size_t)(k0 + k) * ldsrc + srccol0 + n] : 0.f;
    }
  }
  __syncthreads();
  {
    const int k = tid & 63, nn = tid >> 6;
#pragma unroll
    for (int i = 0; i < 8; ++i) {
      const int n = nn + 8 * i;
      dst[(size_t)(n0 + n) * lddst + k0 + k] = f2bf(lds[k * 65 + n] * scale);
    }
  }
  __syncthreads();
}

DI void prep_item(const Params& P, int item, bf16_t* ldsb, int tid) {
  float* lds = (float*)ldsb;
  constexpr int PER_LAYER = 4800;
  if (item < 2 * PER_LAYER) {
    const int l = item / PER_LAYER; int it = item - l * PER_LAYER;
    bf16_t* wb = (bf16_t*)(P.ws + OFF_W) + (size_t)l * W_LAYER;
    if (it < 1792) {
      const int ntile = it >> 4, kt = it & 15;
      const int n0 = ntile * 64;
      int srccol0, nvalid;
      if (n0 < 2048) { srccol0 = n0; nvalid = 64; }
      else if (n0 < 6912) { srccol0 = n0 + 16; nvalid = 64; }
      else if (n0 == 6912) { srccol0 = 2048; nvalid = 16; }
      else { srccol0 = 0; nvalid = 0; }
      transpose_tile(P.in[I_WIN] + (size_t)l * 1024 * N_IN, N_IN, kt * 64, srccol0, nvalid, wb + W_IN, 1024, n0, 1.f, lds, tid);
      return;
    }
    it -= 1792;
    if (it < 192) {
      const int mh = it >> 4, tt = it & 15;
      const int which = mh >> 2, head = mh & 3;
      const float* src = P.in[I_WQ + which] + ((size_t)(l * 4 + head)) * 65536;
      transpose_tile(src, 256, (tt & 3) * 64, (tt >> 2) * 64, 64, wb + W_QKV + (size_t)mh * 65536, 256, (tt >> 2) * 64,
                     which == 1 ? 0.0625f : 1.f, lds, tid);
      return;
    }
    it -= 192;
    if (it < 256) { transpose_tile(P.in[I_PM] + (size_t)l * 1024 * 1024, 1024, (it & 15) * 64, (it >> 4) * 64, 64, wb + W_PM, 1024, (it >> 4) * 64, 1.f, lds, tid); return; }
    it -= 256;
    if (it < 128) { transpose_tile(P.in[I_PA] + (size_t)l * 512 * 1024, 1024, (it & 7) * 64, (it >> 3) * 64, 64, wb + W_PA, 1024, (it >> 3) * 64, 1.f, lds, tid); return; }
    it -= 128;
    if (it < 128) { transpose_tile(P.in[I_PC] + (size_t)l * 512 * 1024, 1024, (it & 7) * 64, (it >> 3) * 64, 64, wb + W_PC, 1024, (it >> 3) * 64, 1.f, lds, tid); return; }
    it -= 128;
    if (it < 256) { transpose_tile(P.in[I_WOUT] + (size_t)l * 1024 * 1024, 1024, (it & 15) * 64, (it >> 4) * 64, 64, wb + W_OUT, 1024, (it >> 4) * 64, 1.f, lds, tid); return; }
    it -= 256;
    if (it < 1024) { transpose_tile(P.in[I_W1] + (size_t)l * 1024 * 4096, 4096, (it & 15) * 64, (it >> 4) * 64, 64, wb + W_1, 1024, (it >> 4) * 64, 1.f, lds, tid); return; }
    it -= 1024;
    transpose_tile(P.in[I_W2] + (size_t)l * 4096 * 1024, 1024, (it & 63) * 64, (it >> 6) * 64, 64, wb + W_2, 4096, (it >> 6) * 64, 1.f, lds, tid);
    return;
  }
  item -= 2 * PER_LAYER;
  if (item < 2) {
    const int l = item;
    float* bp = (float*)(P.ws + OFF_BINP) + l * N_INP;
    const float* b = P.in[I_BIN] + (size_t)l * N_IN;
    for (int n = tid; n < N_INP; n += NT) {
      float v = 0.f;
      if (n < 2048) v = b[n]; else if (n < 6912) v = b[n + 16]; else if (n < 6928) v = b[2048 + n - 6912];
      bp[n] = v;
    }
    return;
  }
  item -= 2;
  {
    const int bh = item & 1, cc = (item >> 1) % 48, l = item / 96;
    for (int idx = tid; idx < 1024 * 24; idx += NT) {
      const int k = idx / 24, b = idx - k * 24, bg = bh * 24 + b;
      const float c = (bg < 32) ? P.in[I_CP][bg * 1024 + k] : P.in[I_CS][(bg - 32) * 1024 + k];
      lds[idx] = c / (1.f + __expf(-c));
    }
    __syncthreads();
    const int cl = tid & 127, kq = tid >> 7, col = cc * 128 + cl;
    float acc[24];
#pragma unroll
    for (int b = 0; b < 24; ++b) acc[b] = 0.f;
    const float* w = P.in[I_ADAW] + (size_t)l * 1024 * 6144 + col;
    for (int k = kq * 256; k < kq * 256 + 256; ++k) {
      const float wv = w[(size_t)k * 6144];
      const float4* s4 = (const float4*)(lds + k * 24);
#pragma unroll
      for (int q = 0; q < 6; ++q) {
        const float4 s = s4[q];
        acc[4 * q] += wv * s.x; acc[4 * q + 1] += wv * s.y; acc[4 * q + 2] += wv * s.z; acc[4 * q + 3] += wv * s.w;
      }
    }
    __syncthreads();
#pragma unroll
    for (int b = 0; b < 24; ++b) lds[(kq * 24 + b) * 128 + cl] = acc[b];
    __syncthreads();
    float* mod = (float*)(P.ws + OFF_MOD);
    for (int idx = tid; idx < 24 * 128; idx += NT) {
      const int b = idx >> 7, c = idx & 127;
      const float v = lds[(0 * 24 + b) * 128 + c] + lds[(1 * 24 + b) * 128 + c] + lds[(2 * 24 + b) * 128 + c] + lds[(3 * 24 + b) * 128 + c] +
                      P.in[I_ADAB][l * 6144 + cc * 128 + c];
      mod[((size_t)(l * NSEQ_ALL + bh * 24 + b)) * 6144 + cc * 128 + c] = v;
    }
    __syncthreads();
  }
}
constexpr int PREP_ITEMS = 2 * 4800 + 2 + 192;

DI void phase_xm0(const Ctx& c) {
  const float* x = c.xin();
  bf16_t* xm = (bf16_t*)(c.ws() + OFF_R0);
  const size_t n8 = (size_t)TG * D / 8;
  for (size_t i = (size_t)c.bid * NT + c.tid; i < n8; i += (size_t)c.nb * NT) {
    const int row = (int)(i >> 7), col = (int)(i & 127) * 8;
    const float4 v0 = *(const float4*)(x + i * 8), v1 = *(const float4*)(x + i * 8 + 4);
    const float* scp = c.mod(1, row >> 11) + col; const float* shp = c.mod(0, row >> 11) + col;
    const float4 sc0 = *(const float4*)scp, sc1 = *(const float4*)(scp + 4), sh0 = *(const float4*)shp, sh1 = *(const float4*)(shp + 4);
    uint4 o;
    o.x = pack2(v0.x * (1.f + sc0.x) + sh0.x, v0.y * (1.f + sc0.y) + sh0.y); o.y = pack2(v0.z * (1.f + sc0.z) + sh0.z, v0.w * (1.f + sc0.w) + sh0.w);
    o.z = pack2(v1.x * (1.f + sc1.x) + sh1.x, v1.y * (1.f + sc1.y) + sh1.y); o.w = pack2(v1.z * (1.f + sc1.z) + sh1.z, v1.w * (1.f + sc1.w) + sh1.w);
    *(uint4*)(xm + i * 8) = o;
  }
}

DI void phase_conv(const Ctx& c) {
  const bf16_t* proj = (const bf16_t*)(c.ws() + OFF_R1);
  bf16_t* xc = (bf16_t*)(c.ws() + OFF_R2);
  float* wl = (float*)c.lds;
  for (int i = c.tid; i < 6 * 1024; i += NT) wl[i] = (i < 5120) ? c.in(I_CONVW)[(size_t)c.l * 5120 + i] : c.in(I_CONVB)[(size_t)c.l * 1024 + i - 5120];
  __syncthreads();
  const size_t n16 = (size_t)TG * 64, stride = (size_t)c.nb * NT;
  const int ch = (c.tid & 63) * 16;
  size_t i = (size_t)c.bid * NT + c.tid;
  uint4 v[5][2], nv[5][2];
  auto load_rows = [&](size_t idx, uint4 (&dst)[5][2]) {
    const int row = (int)(idx >> 6), s = row & (SEQ - 1);
#pragma unroll
    for (int tp = 0; tp < 5; ++tp) {
      const int ss = s + tp - 2;
      if (ss >= 0 && ss < SEQ) {
        const bf16_t* p = proj + (size_t)(row + tp - 2) * LDP + P_XM + ch;
        dst[tp][0] = *(const uint4*)p; dst[tp][1] = *(const uint4*)(p + 8);
      } else { dst[tp][0] = make_uint4(0, 0, 0, 0); dst[tp][1] = make_uint4(0, 0, 0, 0); }
    }
  };
  if (i < n16) load_rows(i, v);
  for (; i < n16; i += stride) {
    const int row = (int)(i >> 6);
    const bool more = i + stride < n16;
    if (more) load_rows(i + stride, nv);
    uint4 o[2];
#pragma unroll
    for (int hh = 0; hh < 2; ++hh) {
      float acc[8];
      const int c0 = ch + hh * 8;
      const float4 cb0 = *(const float4*)(wl + 5120 + c0), cb1 = *(const float4*)(wl + 5120 + c0 + 4);
      acc[0] = cb0.x; acc[1] = cb0.y; acc[2] = cb0.z; acc[3] = cb0.w; acc[4] = cb1.x; acc[5] = cb1.y; acc[6] = cb1.z; acc[7] = cb1.w;
#pragma unroll
      for (int tp = 0; tp < 5; ++tp) {
        const uint4 u = v[tp][hh];
        const float4 w0 = *(const float4*)(wl + tp * 1024 + c0), w1 = *(const float4*)(wl + tp * 1024 + c0 + 4);
        acc[0] += lo2f(u.x) * w0.x; acc[1] += hi2f(u.x) * w0.y; acc[2] += lo2f(u.y) * w0.z; acc[3] += hi2f(u.y) * w0.w;
        acc[4] += lo2f(u.z) * w1.x; acc[5] += hi2f(u.z) * w1.y; acc[6] += lo2f(u.w) * w1.z; acc[7] += hi2f(u.w) * w1.w;
      }
#pragma unroll
      for (int j = 0; j < 8; ++j) acc[j] = acc[j] * sigmoidf_(acc[j]);
      o[hh].x = pack2(acc[0], acc[1]); o[hh].y = pack2(acc[2], acc[3]); o[hh].z = pack2(acc[4], acc[5]); o[hh].w = pack2(acc[6], acc[7]);
    }
    *(uint4*)(xc + (size_t)row * 1024 + ch) = o[0]; *(uint4*)(xc + (size_t)row * 1024 + ch + 8) = o[1];
    if (more) {
#pragma unroll
      for (int tp = 0; tp < 5; ++tp) { v[tp][0] = nv[tp][0]; v[tp][1] = nv[tp][1]; }
    }
  }
  __syncthreads();
}

DI void phase_post(const Ctx& c) {
  const bf16_t* hf = (const bf16_t*)(c.ws() + OFF_R0);
  bf16_t* hb = (bf16_t*)(c.ws() + OFF_R2);
  const bf16_t* proj = (const bf16_t*)(c.ws() + OFF_R1);
  const float* nw = c.in(I_NORMW) + (size_t)c.l * 1024;
  const int lane = c.tid & 63;
  const int gw = c.bid * (NT / 64) + (c.tid >> 6), nw_ = c.nb * (NT / 64);
  float4 wv[4];
#pragma unroll
  for (int hd = 0; hd < 4; ++hd) wv[hd] = *(const float4*)(nw + hd * 256 + lane * 4);
  for (int idx0 = gw * 4; idx0 < TG * 4; idx0 += nw_ * 4) {
    uint2 a[4], b[4], z[4];
#pragma unroll
    for (int rr = 0; rr < 4; ++rr) {
      const int row = (idx0 + rr) >> 2, head = (idx0 + rr) & 3;
      const size_t base = (size_t)row * 1024 + head * 256 + lane * 4;
      a[rr] = *(const uint2*)(hf + base); b[rr] = *(const uint2*)(hb + base);
      z[rr] = *(const uint2*)(proj + (size_t)row * LDP + P_Z + head * 256 + lane * 4);
    }
#pragma unroll
    for (int rr = 0; rr < 4; ++rr) {
      const int row = (idx0 + rr) >> 2, head = (idx0 + rr) & 3;
      const size_t base = (size_t)row * 1024 + head * 256 + lane * 4;
      float x0 = lo2f(a[rr].x) + lo2f(b[rr].x), x1 = hi2f(a[rr].x) + hi2f(b[rr].x), x2 = lo2f(a[rr].y) + lo2f(b[rr].y), x3 = hi2f(a[rr].y) + hi2f(b[rr].y);
      const float mean = wsum(x0 + x1 + x2 + x3, lane) * (1.f / 256.f);
      x0 -= mean; x1 -= mean; x2 -= mean; x3 -= mean;
      const float var = wsum(x0 * x0 + x1 * x1 + x2 * x2 + x3 * x3, lane) * (1.f / 256.f);
      const float rstd = rsqrtf(var + LN_EPS);
      const float4 w = wv[rr];
      uint2 o;
      o.x = pack2(x0 * rstd * w.x * sigmoidf_(lo2f(z[rr].x)), x1 * rstd * w.y * sigmoidf_(hi2f(z[rr].x)));
      o.y = pack2(x2 * rstd * w.z * sigmoidf_(lo2f(z[rr].y)), x3 * rstd * w.w * sigmoidf_(hi2f(z[rr].y)));
      *(uint2*)(hb + base) = o;
    }
  }
}

DI void phase_ln(const Ctx& c, const bf16_t* pre, const float* xres, const float* w, const float* b, int mod_layer, int mod_sh, int mod_sc) {
  float* xo = c.xout();
  bf16_t* xm = (bf16_t*)(c.ws() + OFF_R0);
  const int lane = c.tid & 63;
  const int gw = c.bid * (NT / 64) + (c.tid >> 6), nw_ = c.nb * (NT / 64);
  float4 ww[4], bb[4];
#pragma unroll
  for (int i = 0; i < 4; ++i) { ww[i] = *(const float4*)(w + i * 256 + lane * 4); bb[i] = *(const float4*)(b + i * 256 + lane * 4); }
  for (int row0 = gw * 4; row0 < TG; row0 += nw_ * 4) {
    float4 v[4][4], sc[4], sh[4];
    const float* modbase = (const float*)(c.ws() + OFF_MOD) + ((size_t)((mod_layer < 0 ? 0 : mod_layer) * NSEQ_ALL + c.g * GSEQ + (row0 >> 11))) * 6144;
#pragma unroll
    for (int rr = 0; rr < 4; ++rr)
#pragma unroll
      for (int i = 0; i < 4; ++i) {
        const size_t off = (size_t)(row0 + rr) * 1024 + i * 256 + lane * 4;
        const uint2 pv = *(const uint2*)(pre + off); const float4 xv = *(const float4*)(xres + off);
        v[rr][i].x = ALPHA * xv.x + lo2f(pv.x); v[rr][i].y = ALPHA * xv.y + hi2f(pv.x); v[rr][i].z = ALPHA * xv.z + lo2f(pv.y); v[rr][i].w = ALPHA * xv.w + hi2f(pv.y);
      }
    if (mod_layer >= 0) {
#pragma unroll
      for (int i = 0; i < 4; ++i) { sc[i] = *(const float4*)(modbase + mod_sc * 1024 + i * 256 + lane * 4); sh[i] = *(const float4*)(modbase + mod_sh * 1024 + i * 256 + lane * 4); }
    }
#pragma unroll
    for (int rr = 0; rr < 4; ++rr) {
      float s = 0.f;
#pragma unroll
      for (int i = 0; i < 4; ++i) s += v[rr][i].x + v[rr][i].y + v[rr][i].z + v[rr][i].w;
      const float mean = wsum(s, lane) * (1.f / 1024.f);
      float q = 0.f;
#pragma unroll
      for (int i = 0; i < 4; ++i) { float4& t = v[rr][i]; t.x -= mean; t.y -= mean; t.z -= mean; t.w -= mean; q += t.x * t.x + t.y * t.y + t.z * t.z + t.w * t.w; }
      const float rstd = rsqrtf(wsum(q, lane) * (1.f / 1024.f) + LN_EPS);
#pragma unroll
      for (int i = 0; i < 4; ++i) {
        float4& t = v[rr][i];
        t.x = t.x * rstd * ww[i].x + bb[i].x; t.y = t.y * rstd * ww[i].y + bb[i].y; t.z = t.z * rstd * ww[i].z + bb[i].z; t.w = t.w * rstd * ww[i].w + bb[i].w;
      }
    }
    asm volatile("" ::: "memory");
#pragma unroll
    for (int rr = 0; rr < 4; ++rr)
#pragma unroll
      for (int i = 0; i < 4; ++i) {
        const size_t off = (size_t)(row0 + rr) * 1024 + i * 256 + lane * 4;
        const float4 y = v[rr][i];
        *(float4*)(xo + off) = y;
        if (mod_layer >= 0) {
          uint2 o; o.x = pack2(y.x * (1.f + sc[i].x) + sh[i].x, y.y * (1.f + sc[i].y) + sh[i].y); o.y = pack2(y.z * (1.f + sc[i].z) + sh[i].z, y.w * (1.f + sc[i].w) + sh[i].w);
          *(uint2*)(xm + off) = o;
        }
      }
  }
}

DI void phase_g1(const Ctx& c) {
  const char* xm = (const char*)(c.ws() + OFF_R0);
  bf16_t* proj = (bf16_t*)(c.ws() + OFF_R1);
  float* gates = (float*)(c.ws() + OFF_GATES);
  const float* binp = (const float*)(c.ws() + OFF_BINP) + c.l * N_INP;
  const char* wt = (const char*)c.W(W_IN);
  constexpr int nM = TG / 256, nN = N_INP / 256;
  auto sched = [&](int i, GUnit& u) -> bool {
    const int L = i * c.nb + c.bid; if (L >= nM * nN) return false;
    static_unit(L, nM, nN, u.pm, u.pn);
    u.A = xm + (size_t)u.pm * 256 * 1024 * 2; u.B = wt + (size_t)u.pn * 256 * 1024 * 2; u.nt = 16; u.tag = 0; return true; };
  auto epi = [&](GAcc& acc, const GUnit& u, int wr, int wc, int fr, int fq) -> bool {
    const int m0 = u.pm * 256, n0 = u.pn * 256;
    const ColVec bv = load_cols(binp + n0, wc, fq);
    if (n0 < P_U) {
      for_rows8b(acc, wr, wc, fr, fq, [&](int rl, int cl, int bj, f32x4 v0, f32x4 v1) {
        *(uint4*)(proj + (size_t)(m0 + rl) * LDP + n0 + cl) = pack8(v0 + bv.v[bj][0], v1 + bv.v[bj][1]); });
    } else if (n0 < P_G) {
      for_rows8b(acc, wr, wc, fr, fq, [&](int rl, int cl, int bj, f32x4 v0, f32x4 v1) {
        v0 += bv.v[bj][0]; v1 += bv.v[bj][1];
#pragma unroll
        for (int j = 0; j < 4; ++j) { v0[j] = gelu_tanh(v0[j]); v1[j] = gelu_tanh(v1[j]); }
        *(uint4*)(proj + (size_t)(m0 + rl) * LDP + n0 + cl) = pack8(v0, v1); });
    } else if (n0 < LDP) {
      for_rows8b(acc, wr, wc, fr, fq, [&](int rl, int cl, int bj, f32x4 v0, f32x4 v1) {
        v0 += bv.v[bj][0]; v1 += bv.v[bj][1];
#pragma unroll
        for (int j = 0; j < 4; ++j) { v0[j] = sigmoidf_(v0[j]); v1[j] = sigmoidf_(v1[j]); }
        *(uint4*)(proj + (size_t)(m0 + rl) * LDP + n0 + cl) = pack8(v0, v1); });
    } else {
      for_rows8b(acc, wr, wc, fr, fq, [&](int rl, int cl, int bj, f32x4 v0, f32x4 v1) {
        if (cl < 16) {
          float* o = gates + (size_t)(m0 + rl) * 16 + cl;
          *(f32x4*)o = v0 + bv.v[bj][0]; *(f32x4*)(o + 4) = v1 + bv.v[bj][1];
        } });
    }
    return false;
  };
  gemm_phase8(c.lds, 1024, 1024, sched, epi, c.tid);
}

DI void phase_g2(const Ctx& c) {
  const char* xc = (const char*)(c.ws() + OFF_R2);
  const char* proj = (const char*)(c.ws() + OFF_R1);
  bf16_t* mq = (bf16_t*)(c.ws() + OFF_R3);
  bf16_t* mk = mq + (size_t)TG * 1024;
  bf16_t* mkt = mk + (size_t)TG * 1024;
  bf16_t* mvt = mkt + (size_t)TG * 1024;
  const char* wqkv = (const char*)c.W(W_QKV);
  constexpr int nM = TG / 256;
  {
    auto sched = [&](int i, GUnit& u) -> bool {
      const int L = i * c.nb + c.bid; if (L >= nM * 8) return false;
      u.pm = L >> 3; u.pn = L & 3; u.tag = (L >> 2) & 1;
      u.A = xc + ((size_t)u.pm * 256 * 1024 + u.pn * 256) * 2; u.B = wqkv + (size_t)(u.tag * 4 + u.pn) * 65536 * 2; u.nt = 4; return true; };
    auto epi = [&](GAcc& acc, const GUnit& u, int wr, int wc, int fr, int fq) -> bool {
      bf16_t* dst = (u.tag ? mk : mq) + (size_t)u.pm * 256 * 1024 + u.pn * 256;
      for_rows8(acc, wr, wc, fr, fq, [&](int rl, int cl, f32x4 v0, f32x4 v1) { *(uint4*)(dst + (size_t)rl * 1024 + cl) = pack8(v0, v1); }); return false; };
    int t1 = c.tid; asm volatile("" : "+v"(t1));
    gemm_phase8(c.lds, 1024, 256, sched, epi, t1);
  }
  {
    auto sched = [&](int i, GUnit& u) -> bool {
      const int L = i * c.nb + c.bid; if (L >= nM * 4) return false;
      u.pm = L >> 2; u.pn = L & 3; u.tag = 0;
      u.A = wqkv + (size_t)(4 + u.pn) * 65536 * 2; u.B = xc + ((size_t)u.pm * 256 * 1024 + u.pn * 256) * 2; u.nt = 4; return true; };
    auto epi = [&](GAcc& acc, const GUnit& u, int wr, int wc, int fr, int fq) -> bool {
      const int tok0 = u.pm * 256, seq = tok0 >> 11, s0 = tok0 & (SEQ - 1);
      bf16_t* dst = mkt + ((size_t)(seq * 4 + u.pn) * 256) * SEQ + s0;
      for_rows8(acc, wr, wc, fr, fq, [&](int rl, int cl, f32x4 v0, f32x4 v1) { *(uint4*)(dst + (size_t)rl * SEQ + cl) = pack8(v0, v1); }); return false; };
    int t2 = c.tid; asm volatile("" : "+v"(t2));
    gemm_phase8(c.lds, 256, 1024, sched, epi, t2);
  }
  {
    auto sched = [&](int i, GUnit& u) -> bool {
      const int L = i * c.nb + c.bid; if (L >= nM * 4) return false;
      u.pm = L >> 2; u.pn = L & 3; u.tag = 0;
      u.A = wqkv + (size_t)(8 + u.pn) * 65536 * 2; u.B = proj + ((size_t)u.pm * 256 * LDP + P_XM + u.pn * 256) * 2; u.nt = 4; return true; };
    auto epi = [&](GAcc& acc, const GUnit& u, int wr, int wc, int fr, int fq) -> bool {
      const int tok0 = u.pm * 256, seq = tok0 >> 11, s0 = tok0 & (SEQ - 1);
      bf16_t* dst = mvt + ((size_t)(seq * 4 + u.pn) * 256) * SEQ + s0;
      for_rows8(acc, wr, wc, fr, fq, [&](int rl, int cl, f32x4 v0, f32x4 v1) { *(uint4*)(dst + (size_t)rl * SEQ + cl) = pack8(v0, v1); }); return false; };
    int t3 = c.tid; asm volatile("" : "+v"(t3));
    gemm_phase8(c.lds, 256, LDP, sched, epi, t3);
  }
}

DI void phase_merge(const Ctx& c) {
  const char* ym = (const char*)(c.ws() + OFF_R2);
  const char* yac = (const char*)(c.ws() + OFF_R5);
  const bf16_t* proj = (const bf16_t*)(c.ws() + OFF_R1);
  bf16_t* merged = (bf16_t*)(c.ws() + OFF_R3);
  const char* wpm = (const char*)c.W(W_PM);
  const char* wpa = (const char*)c.W(W_PA);
  constexpr int nM = TG / 256, nN = 4;
  auto sched = [&](int i, GUnit& u) -> bool {
    const int j = i / 3, b = i - j * 3;
    const int L = j * c.nb + c.bid; if (L >= nM * nN) return false;
    static_unit(L, nM, nN, u.pm, u.pn);
    u.tag = b; u.nt = (b == 0) ? 16 : 8;
    u.A = ((b == 0) ? ym : yac + (b == 2 ? 1024 : 0)) + (size_t)u.pm * 256 * 1024 * 2;
    u.B = ((b == 0) ? wpm : wpa + (b == 2 ? 1024 : 0)) + (size_t)u.pn * 256 * 1024 * 2;
    return true; };
  auto epi = [&](GAcc& acc, const GUnit& u, int wr, int wc, int fr, int fq) -> bool {
    const int m0 = u.pm * 256, n0 = u.pn * 256, b = u.tag;
    const bf16_t* gp = proj + (size_t)(m0 + wr * 64 + fr) * LDP + P_G + b * 1024 + n0 + wc * 32 + 8 * fq;
#pragma unroll
    for (int ai = 0; ai < 2; ++ai) {
      uint4 g[4][2], gn[4][2];
#pragma unroll
      for (int m = 0; m < 4; ++m)
#pragma unroll
        for (int bj = 0; bj < 2; ++bj) {
          const bf16_t* q = gp + (size_t)(ai * 128 + m * 16) * LDP + bj * 128;
          g[m][bj] = *(const uint4*)q;
          if (b < 2) gn[m][bj] = *(const uint4*)(q + 1024);
        }
#pragma unroll
      for (int m = 0; m < 4; ++m)
#pragma unroll
        for (int bj = 0; bj < 2; ++bj) {
          const uint4 gg = g[m][bj];
          f32x4 g0 = {lo2f(gg.x), hi2f(gg.x), lo2f(gg.y), hi2f(gg.y)}, g1 = {lo2f(gg.z), hi2f(gg.z), lo2f(gg.w), hi2f(gg.w)};
          if (b < 2) {
            const uint4 hh = gn[m][bj];
            const f32x4 h0 = {lo2f(hh.x), hi2f(hh.x), lo2f(hh.y), hi2f(hh.y)}, h1 = {lo2f(hh.z), hi2f(hh.z), lo2f(hh.w), hi2f(hh.w)};
#pragma unroll
            for (int j = 0; j < 4; ++j) { g0[j] *= __builtin_amdgcn_rcpf(fmaxf(h0[j], 1e-30f)); g1[j] *= __builtin_amdgcn_rcpf(fmaxf(h1[j], 1e-30f)); }
            acc[ai][bj][m][0] *= g0; acc[ai][bj][m][1] *= g1;
          } else {
            const size_t row = m0 + ai * 128 + wr * 64 + m * 16 + fr; const int col = n0 + bj * 128 + wc * 32 + 8 * fq;
            *(uint4*)(merged + row * 1024 + col) = pack8(g0 * acc[ai][bj][m][0], g1 * acc[ai][bj][m][1]);
          }
        }
    }
    return b < 2;
  };
  gemm_phase8(c.lds, 1024, 1024, sched, epi, c.tid);
}

DI void phase_wout(const Ctx& c) {
  const char* merged = (const char*)(c.ws() + OFF_R3);
  bf16_t* pre = (bf16_t*)(c.ws() + OFF_R3 + 64 * MiB);
  const char* wt = (const char*)c.W(W_OUT);
  constexpr int nM = TG / 256, nN = 4;
  auto sched = [&](int i, GUnit& u) -> bool {
    const int L = i * c.nb + c.bid; if (L >= nM * nN) return false;
    static_unit(L, nM, nN, u.pm, u.pn);
    u.A = merged + (size_t)u.pm * 256 * 1024 * 2; u.B = wt + (size_t)u.pn * 256 * 1024 * 2; u.nt = 16; u.tag = 0; return true; };
  auto epi = [&](GAcc& acc, const GUnit& u, int wr, int wc, int fr, int fq) -> bool {
    const int m0 = u.pm * 256, n0 = u.pn * 256;
    const ColVec gv = load_cols(c.mod(2, m0 >> 11) + n0, wc, fq);
    for_rows8b(acc, wr, wc, fr, fq, [&](int rl, int cl, int bj, f32x4 v0, f32x4 v1) {
      const size_t off = (size_t)(m0 + rl) * 1024 + n0 + cl;
      *(uint4*)(pre + off) = pack8((gv.v[bj][0] + 1.f) * v0, (gv.v[bj][1] + 1.f) * v1); }); return false; };
  gemm_phase8(c.lds, 1024, 1024, sched, epi, c.tid);
}

DI void phase_mlp1(const Ctx& c) {
  const char* xm = (const char*)(c.ws() + OFF_R0);
  bf16_t* hid = (bf16_t*)(c.ws() + OFF_R1);
  const float* b1 = c.in(I_B1) + (size_t)c.l * 4096;
  const char* wt = (const char*)c.W(W_1);
  constexpr int nM = TG / 256, nN = 16;
  auto sched = [&](int i, GUnit& u) -> bool {
    const int L = i * c.nb + c.bid; if (L >= nM * nN) return false;
    static_unit(L, nM, nN, u.pm, u.pn);
    u.A = xm + (size_t)u.pm * 256 * 1024 * 2; u.B = wt + (size_t)u.pn * 256 * 1024 * 2; u.nt = 16; u.tag = 0; return true; };
  auto epi = [&](GAcc& acc, const GUnit& u, int wr, int wc, int fr, int fq) -> bool {
    const int m0 = u.pm * 256, n0 = u.pn * 256;
    const ColVec bv = load_cols(b1 + n0, wc, fq);
    for_rows8b(acc, wr, wc, fr, fq, [&](int rl, int cl, int bj, f32x4 v0, f32x4 v1) {
      v0 += bv.v[bj][0]; v1 += bv.v[bj][1];
#pragma unroll
      for (int j = 0; j < 4; ++j) { const float a = fmaxf(v0[j], 0.f), b = fmaxf(v1[j], 0.f); v0[j] = a * a; v1[j] = b * b; }
      *(uint4*)(hid + (size_t)(m0 + rl) * 4096 + n0 + cl) = pack8(v0, v1); }); return false; };
  gemm_phase8(c.lds, 1024, 1024, sched, epi, c.tid);
}

DI void phase_mlp2(const Ctx& c) {
  const char* hid = (const char*)(c.ws() + OFF_R1);
  bf16_t* pre = (bf16_t*)(c.ws() + OFF_R1 + 256 * MiB);
  const float* b2 = c.in(I_B2) + (size_t)c.l * 1024;
  const char* wt = (const char*)c.W(W_2);
  constexpr int nM = TG / 256, nN = 4;
  auto sched = [&](int i, GUnit& u) -> bool {
    const int L = i * c.nb + c.bid; if (L >= nM * nN) return false;
    static_unit(L, nM, nN, u.pm, u.pn);
    u.A = hid + (size_t)u.pm * 256 * 4096 * 2; u.B = wt + (size_t)u.pn * 256 * 4096 * 2; u.nt = 64; u.tag = 0; return true; };
  auto epi = [&](GAcc& acc, const GUnit& u, int wr, int wc, int fr, int fq) -> bool {
    const int m0 = u.pm * 256, n0 = u.pn * 256;
    const ColVec gv = load_cols(c.mod(5, m0 >> 11) + n0, wc, fq), bv = load_cols(b2 + n0, wc, fq);
    for_rows8b(acc, wr, wc, fr, fq, [&](int rl, int cl, int bj, f32x4 v0, f32x4 v1) {
      const size_t off = (size_t)(m0 + rl) * 1024 + n0 + cl;
      *(uint4*)(pre + off) = pack8((gv.v[bj][0] + 1.f) * (v0 + bv.v[bj][0]), (gv.v[bj][1] + 1.f) * (v1 + bv.v[bj][1])); }); return false; };
  gemm_phase8(c.lds, 4096, 4096, sched, epi, c.tid);
}

DI void gate_prepass(const Ctx& c) {
  const float* gates = (const float*)(c.ws() + OFF_GATES);
  float* ga = (float*)(c.ws() + OFF_GPRE);
  float* gb = ga + 128 * SEQ; float* gc = gb + 128 * SEQ; float* gt = gc + 128 * SEQ;
  const int lane = c.tid & 63;
  const int gw = c.bid * (NT / 64) + (c.tid >> 6), nw_ = c.nb * (NT / 64);
  for (int idx = gw; idx < GSEQ * 4 * 2 * 32; idx += nw_) {
    const int cj = idx & 31, dir = (idx >> 5) & 1, head = (idx >> 6) & 3, seq = idx >> 8;
    const int p = dir ? 63 - lane : lane;
    const int t = seq * SEQ + cj * 64 + p;
    const float ig = gates[(size_t)t * 16 + dir * 8 + head];
    const float fg = gates[(size_t)t * 16 + dir * 8 + 4 + head];
    float a = fminf(fg, 0.f) - log1pf(__expf(-fabsf(fg)));
#pragma unroll
    for (int o = 1; o < 64; o <<= 1) { const float tt = bperm(lane - o, a); if (lane >= o) a += tt; }
    const float b = ig - a;
    float cmb = b;
#pragma unroll
    for (int o = 1; o < 64; o <<= 1) { const float tt = bperm(lane - o, cmb); if (lane >= o) cmb = fmaxf(cmb, tt); }
    const size_t base = (size_t)((seq * 4 + head) * 2 + dir) * SEQ + cj * 64 + p;
    ga[base] = a; gb[base] = b; gc[base] = cmb;
    if (lane == 63) { float* g2 = gt + ((seq * 4 + head) * 2 + dir) * 64 + cj * 2; g2[0] = a; g2[1] = cmb; }
  }
}

#define MFMA16(a, b, c) __builtin_amdgcn_mfma_f32_16x16x32_bf16((a), (b), (c), 0, 0, 0)
DI bf16x8 frag_from(uint2 lo, uint2 hi) { uint4 u; u.x = lo.x; u.y = lo.y; u.z = hi.x; u.w = hi.y; return __builtin_bit_cast(bf16x8, u); }
DI bf16x8 frag_pack(f32x4 lo, f32x4 hi) { uint4 u; u.x = pack2(lo[0], lo[1]); u.y = pack2(lo[2], lo[3]); u.z = pack2(hi[0], hi[1]); u.w = pack2(hi[2], hi[3]); return __builtin_bit_cast(bf16x8, u); }

DI void scan_item(const Ctx& c, int item) {
  const int vh = item & 1, dir = (item >> 1) & 1, head = (item >> 2) & 3, seq = item >> 4;
  const int tid = c.tid, lane = tid & 63, wave = tid >> 6, n16 = lane & 15, q4 = lane >> 4;
  const bf16_t* mq = (const bf16_t*)(c.ws() + OFF_R3);
  const bf16_t* mk = mq + (size_t)TG * 1024;
  const bf16_t* mkt = mk + (size_t)TG * 1024;
  const bf16_t* mvt = mkt + (size_t)TG * 1024;
  const float* gpre = (const float*)(c.ws() + OFF_GPRE);
  bf16_t* hout = (bf16_t*)(c.ws() + (dir ? OFF_R2 : OFF_R0));
  bf16_t* Qs = c.lds;
  bf16_t* Ks = Qs + 16896;
  bf16_t* KTs = Ks + 16896;
  bf16_t* VT = KTs + 18432;
  bf16_t* VTs = VT + 9216;
  bf16_t* Ps = VTs + 9216;
  float* fl = (float*)(Ps + 4608);
  float* ns = fl;
  float* abc_s = fl + 256;
  float* a_s = abc_s; float* b_s = abc_s + 64; float* c_s = abc_s + 128;
  float* wg_s = abc_s + 192; float* den_s = wg_s + 64; float* gt_s = den_s + 64; float* winter_s = gt_s + 64; float* emrow_s = winter_s + 64;

  f32x4 cst[16];
#pragma unroll
  for (int kt = 0; kt < 16; ++kt) cst[kt] = (f32x4){0.f, 0.f, 0.f, 0.f};
  float nreg = 0.f, mstate = 0.f;
  if (tid < 256) ns[tid] = 0.f;
  const int gidx = (seq * 4 + head) * 2 + dir;
  if (tid < 64) gt_s[tid] = gpre[(size_t)3 * 128 * SEQ + gidx * 64 + tid];
  const size_t tbase = (size_t)(seq * 4 + head) * 256;
  const int lrow = tid >> 5, lkc = (tid & 31) * 8;
  const bf16_t* qsrc = mq + (size_t)(seq * SEQ + lrow) * 1024 + head * 256 + lkc;
  const bf16_t* ksrc = mk + (size_t)(seq * SEQ + lrow) * 1024 + head * 256 + lkc;
  const bf16_t* vsrc = mvt + (tbase + vh * 128 + (tid >> 3)) * SEQ + (tid & 7) * 8;
  const bf16_t* ktsrc = mkt + (tbase + (tid >> 3)) * SEQ + (tid & 7) * 8;
  const float* gsrc = gpre + (size_t)(tid >> 6) * 128 * SEQ + (size_t)gidx * SEQ + (tid & 63);
  uint4 rq0, rq1, rq2, rq3, rk0, rk1, rk2, rk3, rt0, rt1, rt2, rt3, rv0, rv1; float rg = 0.f;
#define PF_QK(cn) do { const size_t o_ = (size_t)(cn) * 64 * 1024; \
    rq0 = *(const uint4*)(qsrc + o_); rq1 = *(const uint4*)(qsrc + o_ + 16 * 1024); rq2 = *(const uint4*)(qsrc + o_ + 32 * 1024); rq3 = *(const uint4*)(qsrc + o_ + 48 * 1024); \
    rk0 = *(const uint4*)(ksrc + o_); rk1 = *(const uint4*)(ksrc + o_ + 16 * 1024); rk2 = *(const uint4*)(ksrc + o_ + 32 * 1024); rk3 = *(const uint4*)(ksrc + o_ + 48 * 1024); } while (0)
#define PF_TV(cn) do { \
    rt0 = *(const uint4*)(ktsrc + (cn) * 64); rt1 = *(const uint4*)(ktsrc + (size_t)64 * SEQ + (cn) * 64); \
    rt2 = *(const uint4*)(ktsrc + (size_t)128 * SEQ + (cn) * 64); rt3 = *(const uint4*)(ktsrc + (size_t)192 * SEQ + (cn) * 64); \
    rv0 = *(const uint4*)(vsrc + (cn) * 64); rv1 = *(const uint4*)(vsrc + (size_t)64 * SEQ + (cn) * 64); \
    if (tid < 192) rg = gsrc[(cn) * 64]; } while (0)
#define PUT_QK() do { bf16_t* qd = Qs + lrow * 264 + lkc; bf16_t* kd = Ks + lrow * 264 + lkc; \
    *(uint4*)(qd) = rq0; *(uint4*)(qd + 16 * 264) = rq1; *(uint4*)(qd + 32 * 264) = rq2; *(uint4*)(qd + 48 * 264) = rq3; \
    *(uint4*)(kd) = rk0; *(uint4*)(kd + 16 * 264) = rk1; *(uint4*)(kd + 32 * 264) = rk2; *(uint4*)(kd + 48 * 264) = rk3; } while (0)
  PF_QK(dir ? 31 : 0); PF_TV(dir ? 31 : 0);
  PUT_QK();
  __syncthreads();

#pragma unroll 1
  for (int j = 0; j < 32; ++j) {
    const int cj = dir ? 31 - j : j;
    const int t0 = seq * SEQ + cj * 64;
    const float Atot = gt_s[cj * 2], cmbl = gt_s[cj * 2 + 1];
    const float m_new = Atot + fmaxf(mstate, cmbl);
    const float decay = __expf(Atot + mstate - m_new);
    {
      bf16_t* kw = KTs + (tid >> 3) * 72 + (tid & 7) * 8;
      *(uint4*)(kw) = rt0; *(uint4*)(kw + 64 * 72) = rt1; *(uint4*)(kw + 128 * 72) = rt2; *(uint4*)(kw + 192 * 72) = rt3;
      bf16_t* vw = VT + (tid >> 3) * 72 + (tid & 7) * 8;
      *(uint4*)(vw) = rv0; *(uint4*)(vw + 64 * 72) = rv1;
      if (tid < 192) abc_s[tid] = rg;
      if (tid >= 128 && tid < 192) winter_s[tid - 128] = __expf(mstate - fmaxf(mstate, rg));
    }
    __syncthreads();
    {
      const int sc = (tid & 7) * 8;
      const float4 q0 = *(const float4*)(b_s + sc), q1 = *(const float4*)(b_s + sc + 4);
      const float e0 = Atot - m_new;
      const float w0 = __expf(e0 + q0.x), w1 = __expf(e0 + q0.y), w2 = __expf(e0 + q0.z), w3 = __expf(e0 + q0.w);
      const float w4_ = __expf(e0 + q1.x), w5 = __expf(e0 + q1.y), w6 = __expf(e0 + q1.z), w7 = __expf(e0 + q1.w);
#pragma unroll
      for (int i = 0; i < 2; ++i) {
        const int v = (tid >> 3) + 64 * i;
        const uint4 raw = *(const uint4*)(VT + v * 72 + sc);
        uint4 o;
        o.x = pack2(lo2f(raw.x) * w0, hi2f(raw.x) * w1); o.y = pack2(lo2f(raw.y) * w2, hi2f(raw.y) * w3);
        o.z = pack2(lo2f(raw.z) * w4_, hi2f(raw.z) * w5); o.w = pack2(lo2f(raw.w) * w6, hi2f(raw.w) * w7);
        *(uint4*)(VTs + v * 72 + sc) = o;
      }
      if (tid < 64) { wg_s[tid] = __expf(e0 + b_s[tid]); emrow_s[tid] = __expf(-(a_s[tid] + fmaxf(mstate, c_s[tid]))); }
    }
    {
      const int lt = wave >> 1, st0 = (wave & 1) * 2;
      f32x4 sacc0 = {0.f, 0.f, 0.f, 0.f}, sacc1 = {0.f, 0.f, 0.f, 0.f};
      const bf16_t* ap = Qs + (16 * lt + n16) * 264 + 8 * q4;
      const bf16_t* bp = Ks + (16 * st0 + n16) * 264 + 8 * q4;
#pragma unroll
      for (int kk = 0; kk < 8; ++kk) {
        const bf16x8 a = *(const bf16x8*)(ap + 32 * kk);
        sacc0 = MFMA16(a, *(const bf16x8*)(bp + 32 * kk), sacc0);
        sacc1 = MFMA16(a, *(const bf16x8*)(bp + 16 * 264 + 32 * kk), sacc1);
      }
#pragma unroll
      for (int i = 0; i < 2; ++i) {
        const int scol = 16 * (st0 + i) + n16;
        const float bcol = b_s[scol];
#pragma unroll
        for (int jj = 0; jj < 4; ++jj) {
          const int lr = 16 * lt + 4 * q4 + jj;
          const bool valid = dir ? (scol >= lr) : (scol <= lr);
          const float sv = i ? sacc1[jj] : sacc0[jj];
          const float pv = valid ? sv * __expf(bcol - fmaxf(mstate, c_s[lr])) : 0.f;
          Ps[lr * 72 + scol] = f2bf(pv);
        }
      }
    }
    f32x4 iacc[4];
#pragma unroll
    for (int lt = 0; lt < 4; ++lt) iacc[lt] = (f32x4){0.f, 0.f, 0.f, 0.f};
#pragma unroll
    for (int kb = 0; kb < 8; ++kb) {
      const bf16x8 bfrag = frag_pack(cst[2 * kb], cst[2 * kb + 1]);
#pragma unroll
      for (int lt = 0; lt < 4; ++lt) {
        const bf16_t* qp = Qs + (16 * lt + n16) * 264 + 32 * kb + 4 * q4;
        iacc[lt] = MFMA16(frag_from(*(const uint2*)qp, *(const uint2*)(qp + 16)), bfrag, iacc[lt]);
      }
      __builtin_amdgcn_sched_barrier(0);
    }
#pragma unroll
    for (int lt = 0; lt < 4; ++lt) iacc[lt] *= *(const f32x4*)(winter_s + 16 * lt + 4 * q4);
    __syncthreads();
    if (j + 1 < 32) { PF_QK(dir ? cj - 1 : cj + 1); PF_TV(dir ? cj - 1 : cj + 1); }
#pragma unroll
    for (int ss = 0; ss < 2; ++ss) {
      const bf16x8 b = *(const bf16x8*)(VT + (16 * wave + n16) * 72 + 32 * ss + 8 * q4);
#pragma unroll
      for (int lt = 0; lt < 4; ++lt) iacc[lt] = MFMA16(*(const bf16x8*)(Ps + (16 * lt + n16) * 72 + 32 * ss + 8 * q4), b, iacc[lt]);
    }
    {
      const int l = tid >> 3, part = tid & 7;
      float qn = 0.f;
#pragma unroll
      for (int i = 0; i < 4; ++i) {
        const uint4 q = *(const uint4*)(Qs + l * 264 + part * 32 + i * 8);
        const float4 n0 = *(const float4*)(ns + part * 32 + i * 8), n1 = *(const float4*)(ns + part * 32 + i * 8 + 4);
        qn += lo2f(q.x) * n0.x + hi2f(q.x) * n0.y + lo2f(q.y) * n0.z + hi2f(q.y) * n0.w + lo2f(q.z) * n1.x + hi2f(q.z) * n1.y + lo2f(q.w) * n1.z +
              hi2f(q.w) * n1.w;
      }
      const uint4 pq = *(const uint4*)(Ps + l * 72 + part * 8);
      const float ps = lo2f(pq.x) + hi2f(pq.x) + lo2f(pq.y) + hi2f(pq.y) + lo2f(pq.z) + hi2f(pq.z) + lo2f(pq.w) + hi2f(pq.w);
      float tot = ps + winter_s[l] * qn;
      tot += sx<1>(tot); tot += sx<2>(tot); tot += sx<4>(tot);
      if (part == 0) den_s[l] = tot;
    }
    __syncthreads();
#pragma unroll
    for (int lt = 0; lt < 4; ++lt)
#pragma unroll
      for (int jj = 0; jj < 4; ++jj) {
        const int lr = 16 * lt + 4 * q4 + jj;
        const float d = fmaxf(fabsf(den_s[lr]), emrow_s[lr]);
        hout[(size_t)(t0 + lr) * 1024 + head * 256 + vh * 128 + 16 * wave + n16] = f2bf(iacc[lt][jj] * __builtin_amdgcn_rcpf(d));
      }
    if (tid < 256) {
      float s = 0.f;
#pragma unroll
      for (int i = 0; i < 8; ++i) {
        const uint4 q = *(const uint4*)(KTs + tid * 72 + i * 8);
        const float4 g0 = *(const float4*)(wg_s + i * 8), g1 = *(const float4*)(wg_s + i * 8 + 4);
        s += lo2f(q.x) * g0.x + hi2f(q.x) * g0.y + lo2f(q.y) * g0.z + hi2f(q.y) * g0.w + lo2f(q.z) * g1.x + hi2f(q.z) * g1.y + lo2f(q.w) * g1.z +
             hi2f(q.w) * g1.w;
      }
      nreg = decay * nreg + s;
      ns[tid] = nreg;
    }
    {
      const bf16_t* bp = VTs + (16 * wave + n16) * 72 + 8 * q4;
      const bf16x8 b0 = *(const bf16x8*)(bp), b1 = *(const bf16x8*)(bp + 32);
      const bf16_t* ap = KTs + n16 * 72 + 8 * q4;
#pragma unroll
      for (int kt = 0; kt < 16; ++kt) {
        cst[kt] *= decay;
        cst[kt] = MFMA16(*(const bf16x8*)(ap + kt * 16 * 72), b0, cst[kt]);
        cst[kt] = MFMA16(*(const bf16x8*)(ap + kt * 16 * 72 + 32), b1, cst[kt]);
        if ((kt & 3) == 3) __builtin_amdgcn_sched_barrier(0);
      }
    }
    if (j + 1 < 32) PUT_QK();
    mstate = m_new;
    __syncthreads();
  }
#undef PF_QK
#undef PF_TV
#undef PUT_QK
}

DI void attn_item(const Ctx& c, int item) {
  const int kvg = item & 1, hh = (item >> 1) & 1, qb = (item >> 2) & 15, seq = item >> 6;
  const int tid = c.tid, lane = tid & 63, wave = tid >> 6, r = lane & 31, h = lane >> 5;
  const bf16_t* proj = (const bf16_t*)(c.ws() + OFF_R1);
  bf16_t* ya = (bf16_t*)(c.ws() + OFF_R5);
  bf16_t* Kt = c.lds;
  bf16_t* VTt = Kt + 9216;
  const int head = kvg * 4 + hh * 2 + (wave >> 2), slice = wave & 3;
  const float slope = exp2f(-(float)(head + 1));
  const float sink = c.in(I_SINK)[c.l * 8 + head];
  const int q0 = qb * 128 + slice * 32;
  bf16x8 qf[4];
#pragma unroll
  for (int ks = 0; ks < 4; ++ks)
    qf[ks] = *(const bf16x8*)(proj + (size_t)(seq * SEQ + q0 + r) * LDP + P_AQ + head * 64 + ks * 16 + h * 8);
  f32x16 O[2];
#pragma unroll
  for (int e = 0; e < 16; ++e) { O[0][e] = 0.f; O[1][e] = 0.f; }
  float mrun = sink, lsum = 0.f;
  const int kb_lo = (qb == 0) ? 1 : 0, kb_hi = (qb == 15) ? 2 : 3;
  const int kkey = tid >> 3, kdc = (tid & 7) * 8, vkey = tid & 127, vdc = (tid >> 7) * 16;
  const bf16_t* kbase = proj + (size_t)(seq * SEQ + qb * 128 - 128) * LDP + P_AK + kvg * 64;
  const bf16_t* vbase = proj + (size_t)(seq * SEQ + qb * 128 - 128) * LDP + P_AV + kvg * 64;
  uint4 rk0, rk1, rv0, rv1;
  {
    const size_t o = (size_t)kb_lo * 128 * LDP;
    rk0 = *(const uint4*)(kbase + o + (size_t)kkey * LDP + kdc); rk1 = *(const uint4*)(kbase + o + (size_t)(kkey + 64) * LDP + kdc);
    rv0 = *(const uint4*)(vbase + o + (size_t)vkey * LDP + vdc); rv1 = *(const uint4*)(vbase + o + (size_t)vkey * LDP + vdc + 8);
  }
#pragma unroll 1
  for (int kb = kb_lo; kb < kb_hi; ++kb) {
    const int kstart = qb * 128 - 128 + kb * 128;
    *(uint4*)(Kt + kkey * 72 + kdc) = rk0; *(uint4*)(Kt + (kkey + 64) * 72 + kdc) = rk1;
    {
      bf16_t* vd = VTt + vdc * 136 + vkey;
      vd[0 * 136] = (bf16_t)(rv0.x & 0xffff); vd[1 * 136] = (bf16_t)(rv0.x >> 16); vd[2 * 136] = (bf16_t)(rv0.y & 0xffff); vd[3 * 136] = (bf16_t)(rv0.y >> 16);
      vd[4 * 136] = (bf16_t)(rv0.z & 0xffff); vd[5 * 136] = (bf16_t)(rv0.z >> 16); vd[6 * 136] = (bf16_t)(rv0.w & 0xffff); vd[7 * 136] = (bf16_t)(rv0.w >> 16);
      vd[8 * 136] = (bf16_t)(rv1.x & 0xffff); vd[9 * 136] = (bf16_t)(rv1.x >> 16); vd[10 * 136] = (bf16_t)(rv1.y & 0xffff); vd[11 * 136] = (bf16_t)(rv1.y >> 16);
      vd[12 * 136] = (bf16_t)(rv1.z & 0xffff); vd[13 * 136] = (bf16_t)(rv1.z >> 16); vd[14 * 136] = (bf16_t)(rv1.w & 0xffff); vd[15 * 136] = (bf16_t)(rv1.w >> 16);
    }
    __syncthreads();
    if (kb + 1 < kb_hi) {
      const size_t o = (size_t)(kb + 1) * 128 * LDP;
      rk0 = *(const uint4*)(kbase + o + (size_t)kkey * LDP + kdc); rk1 = *(const uint4*)(kbase + o + (size_t)(kkey + 64) * LDP + kdc);
      rv0 = *(const uint4*)(vbase + o + (size_t)vkey * LDP + vdc); rv1 = *(const uint4*)(vbase + o + (size_t)vkey * LDP + vdc + 8);
    }
    f32x16 s[4];
#pragma unroll
    for (int nt = 0; nt < 4; ++nt) {
#pragma unroll
      for (int e = 0; e < 16; ++e) s[nt][e] = 0.f;
#pragma unroll
      for (int ks = 0; ks < 4; ++ks) s[nt] = MFMA(*(const bf16x8*)(Kt + (nt * 32 + r) * 72 + ks * 16 + h * 8), qf[ks], s[nt]);
    }
    const int drel = kstart - (q0 + r);
    float mx = -INFINITY;
#pragma unroll
    for (int nt = 0; nt < 4; ++nt)
#pragma unroll
      for (int e = 0; e < 16; ++e) {
        const int dist = abs(drel + nt * 32 + crow(e, h));
        const float v = (dist <= 128) ? s[nt][e] * 0.125f - slope * (float)dist : -INFINITY;
        s[nt][e] = v; mx = fmaxf(mx, v);
      }
    mx = fmaxf(mx, bperm(lane ^ 32, mx));
    const float mn = fmaxf(mrun, mx);
    const float alpha = __expf(mrun - mn);
    mrun = mn;
    float ls = 0.f;
#pragma unroll
    for (int nt = 0; nt < 4; ++nt)
#pragma unroll
      for (int e = 0; e < 16; ++e) { const float pv = __expf(s[nt][e] - mn); s[nt][e] = pv; ls += pv; }
    lsum = lsum * alpha + ls;
#pragma unroll
    for (int e = 0; e < 16; ++e) { O[0][e] *= alpha; O[1][e] *= alpha; }
#pragma unroll
    for (int nt = 0; nt < 4; ++nt)
#pragma unroll
      for (int s2 = 0; s2 < 2; ++s2) {
        uint4 pu;
        pu.x = pack2(s[nt][8 * s2], s[nt][8 * s2 + 1]); pu.y = pack2(s[nt][8 * s2 + 2], s[nt][8 * s2 + 3]);
        pu.z = pack2(s[nt][8 * s2 + 4], s[nt][8 * s2 + 5]); pu.w = pack2(s[nt][8 * s2 + 6], s[nt][8 * s2 + 7]);
        const bf16x8 pfrag = __builtin_bit_cast(bf16x8, pu);
        const bf16_t* vp = VTt + r * 136 + nt * 32 + 16 * s2 + 4 * h;
        O[0] = MFMA(frag_from(*(const uint2*)vp, *(const uint2*)(vp + 8)), pfrag, O[0]);
        O[1] = MFMA(frag_from(*(const uint2*)(vp + 32 * 136), *(const uint2*)(vp + 32 * 136 + 8)), pfrag, O[1]);
      }
    __syncthreads();
  }
  float l = lsum + bperm(lane ^ 32, lsum);
  l += __expf(sink - mrun);
  const float inv = 1.f / l;
  bf16_t* op = ya + (size_t)(seq * SEQ + q0 + r) * 1024 + head * 64 + 4 * h;
#pragma unroll
  for (int dt = 0; dt < 2; ++dt)
#pragma unroll
    for (int g = 0; g < 4; ++g) {
      uint2 o; o.x = pack2(O[dt][4 * g] * inv, O[dt][4 * g + 1] * inv); o.y = pack2(O[dt][4 * g + 2] * inv, O[dt][4 * g + 3] * inv);
      *(uint2*)(op + dt * 32 + 8 * g) = o;
    }
}

DI void sgu_item(const Ctx& c, int item) {
  const int chunk = item & 15, seq = item >> 4;
  const int tid = c.tid, lane = tid & 63, wave = tid >> 6, r = lane & 31, h = lane >> 5;
  const bf16_t* proj = (const bf16_t*)(c.ws() + OFF_R1);
  bf16_t* yc = (bf16_t*)(c.ws() + OFF_R5) + 512;
  bf16_t* wsb = c.lds;
  bf16_t* vnT = wsb + 128 * 136;
  float* mean_s = (float*)(vnT + 128 * 136); float* rstd_s = mean_s + 128;
  const int t0 = seq * SEQ + chunk * 128;
  const float* lnw = c.in(I_CLNW) + (size_t)c.l * 512;
  const float* lnb = c.in(I_CLNB) + (size_t)c.l * 512;
  {
    const int tok = tid >> 2, part = tid & 3;
    float s = 0.f, q = 0.f;
#pragma unroll
    for (int i = 0; i < 16; ++i) {
      const uint4 v = *(const uint4*)(proj + (size_t)(t0 + tok) * LDP + P_V + part * 128 + i * 8);
      const float f[8] = {lo2f(v.x), hi2f(v.x), lo2f(v.y), hi2f(v.y), lo2f(v.z), hi2f(v.z), lo2f(v.w), hi2f(v.w)};
#pragma unroll
      for (int jj = 0; jj < 8; ++jj) { s += f[jj]; q += f[jj] * f[jj]; }
    }
    s += sx<1>(s); s += sx<2>(s); q += sx<1>(q); q += sx<2>(q);
    const float mean = s * (1.f / 512.f);
    const float var = fmaxf(q * (1.f / 512.f) - mean * mean, 0.f);
    if (part == 0) { mean_s[tok] = mean; rstd_s[tok] = rsqrtf(var + LN_EPS); }
  }
  __syncthreads();
  const int ct = wave >> 1, tt0 = (wave & 1) * 2;
  const int ws_t = tid >> 5, ws_q = (tid & 31) * 4;
  const int vs_s = tid & 127, vs_c = (tid >> 7) * 8;
  float4 rw[8]; uint4 rv[4];
#define SGU_PREFETCH(g_) do { const float* wsg_ = c.in(I_CWS) + ((size_t)(c.l * 4 + (g_))) * 16384; \
    _Pragma("unroll") for (int i = 0; i < 8; ++i) rw[i] = *(const float4*)(wsg_ + (ws_t + 16 * i) * 128 + ws_q); \
    _Pragma("unroll") for (int i = 0; i < 4; ++i) rv[i] = *(const uint4*)(proj + (size_t)(t0 + vs_s) * LDP + P_V + (g_) * 128 + vs_c + 32 * i); } while (0)
  SGU_PREFETCH(0);
#pragma unroll 1
  for (int gq = 0; gq < 4; ++gq) {
#pragma unroll
    for (int i = 0; i < 8; ++i) { uint2 o; o.x = pack2(rw[i].x, rw[i].y); o.y = pack2(rw[i].z, rw[i].w); *(uint2*)(wsb + (ws_t + 16 * i) * 136 + ws_q) = o; }
    {
      const float mean = mean_s[vs_s], rstd = rstd_s[vs_s];
#pragma unroll
      for (int i = 0; i < 4; ++i) {
        const int cc = vs_c + 32 * i;
        const uint4 v = rv[i];
        const float4 w0 = *(const float4*)(lnw + gq * 128 + cc), w1 = *(const float4*)(lnw + gq * 128 + cc + 4);
        const float4 b0 = *(const float4*)(lnb + gq * 128 + cc), b1 = *(const float4*)(lnb + gq * 128 + cc + 4);
        bf16_t* d = vnT + cc * 136 + vs_s;
        d[0 * 136] = f2bf((lo2f(v.x) - mean) * rstd * w0.x + b0.x); d[1 * 136] = f2bf((hi2f(v.x) - mean) * rstd * w0.y + b0.y);
        d[2 * 136] = f2bf((lo2f(v.y) - mean) * rstd * w0.z + b0.z); d[3 * 136] = f2bf((hi2f(v.y) - mean) * rstd * w0.w + b0.w);
        d[4 * 136] = f2bf((lo2f(v.z) - mean) * rstd * w1.x + b1.x); d[5 * 136] = f2bf((hi2f(v.z) - mean) * rstd * w1.y + b1.y);
        d[6 * 136] = f2bf((lo2f(v.w) - mean) * rstd * w1.z + b1.z); d[7 * 136] = f2bf((hi2f(v.w) - mean) * rstd * w1.w + b1.w);
      }
    }
    __syncthreads();
    if (gq < 3) SGU_PREFETCH(gq + 1);
    uint2 u[2][4];
    const float* bs = c.in(I_CBS) + ((size_t)(c.l * 4 + gq)) * 128;
    float bb[2];
#pragma unroll
    for (int i = 0; i < 2; ++i) {
      const int t = (tt0 + i) * 32 + r;
      bb[i] = bs[t];
      const bf16_t* up = proj + (size_t)(t0 + t) * LDP + P_U + gq * 128 + ct * 32 + 4 * h;
#pragma unroll
      for (int g = 0; g < 4; ++g) u[i][g] = *(const uint2*)(up + 8 * g);
    }
    f32x16 acc[2];
#pragma unroll
    for (int e = 0; e < 16; ++e) { acc[0][e] = 0.f; acc[1][e] = 0.f; }
#pragma unroll
    for (int ks = 0; ks < 8; ++ks) {
      const bf16x8 a = *(const bf16x8*)(vnT + (ct * 32 + r) * 136 + ks * 16 + h * 8);
      acc[0] = MFMA(a, *(const bf16x8*)(wsb + (tt0 * 32 + r) * 136 + ks * 16 + h * 8), acc[0]);
      acc[1] = MFMA(a, *(const bf16x8*)(wsb + (tt0 * 32 + 32 + r) * 136 + ks * 16 + h * 8), acc[1]);
    }
#pragma unroll
    for (int i = 0; i < 2; ++i) {
      const int t = (tt0 + i) * 32 + r;
      bf16_t* op = yc + (size_t)(t0 + t) * 1024 + gq * 128 + ct * 32 + 4 * h;
#pragma unroll
      for (int g = 0; g < 4; ++g) {
        uint2 o;
        o.x = pack2(lo2f(u[i][g].x) * (acc[i][4 * g] + bb[i]), hi2f(u[i][g].x) * (acc[i][4 * g + 1] + bb[i]));
        o.y = pack2(lo2f(u[i][g].y) * (acc[i][4 * g + 2] + bb[i]), hi2f(u[i][g].y) * (acc[i][4 * g + 3] + bb[i]));
        *(uint2*)(op + 8 * g) = o;
      }
    }
    __syncthreads();
  }
#undef SGU_PREFETCH
}

DI void phase_mix(const Ctx& c) {
  constexpr int N_SCAN = GSEQ * 16, N_ATT = GSEQ * 64, N_SGU = GSEQ * 16;
  for (int it = c.bid; it < N_SCAN + N_ATT + N_SGU; it += c.nb) {
    Ctx c2 = c;
    asm volatile("" : "+v"(c2.tid));
    asm volatile("" : "+s"(c2.wsp));
    if (it < N_SCAN) { scan_item(c2, it);
#if REPEAT_SCAN
      __syncthreads(); asm volatile("" : "+v"(c2.tid)); scan_item(c2, it);
#endif
    }
    else if (it < N_SCAN + N_ATT) { attn_item(c2, it - N_SCAN);
#if REPEAT_ATT
      __syncthreads(); asm volatile("" : "+v"(c2.tid)); attn_item(c2, it - N_SCAN);
#endif
    }
    else sgu_item(c2, it - N_SCAN - N_ATT);
    __syncthreads();
  }
}

#define XB_TMO      128
#define XB_XCNT(j)  (256  + 64 * (j))
#define XB_XSUB(j)  (1280 + 64 * (j))
#define XB_XGEN(j)  (2304 + 64 * (j))
#define XB_TOP      3328
#define XB_TOPGEN   3392
#define XCD_BAR_WORDS 3456
#define XB_SPIN_CAP (1u << 18)
DI unsigned xb_ld(unsigned* p) { return __hip_atomic_load(p, __ATOMIC_RELAXED, __HIP_MEMORY_SCOPE_AGENT); }
DI unsigned xb_add(unsigned* p, unsigned v) { return __hip_atomic_fetch_add(p, v, __ATOMIC_RELAXED, __HIP_MEMORY_SCOPE_AGENT); }
DI unsigned xb_xcc_id() { return (unsigned)__builtin_amdgcn_s_getreg((3 << 11) | 20) & 0xFu; }
#define XB_SPIN(cond, bar) do { unsigned _sp = 0; while (cond) { __builtin_amdgcn_s_sleep(1); \
    if ((++_sp & 255u) == 0u) { if (xb_ld(&(bar)[XB_TMO])) break; if (_sp > XB_SPIN_CAP) { atomicAdd(&(bar)[XB_TMO], 1u); break; } } } } while (0)
struct XcdBarrier { unsigned* bar; unsigned x; volatile LAS unsigned* st; };
DI XcdBarrier xcd_barrier_post(unsigned* bar, volatile LAS unsigned* st) {
  XcdBarrier b; b.bar = bar; b.x = xb_xcc_id(); b.st = st;
  if (threadIdx.x == 0) (void)xb_add(&bar[XB_XCNT(b.x)], 1u);
  return b;
}
DI void xcd_barrier_complete(unsigned* bar, unsigned x, unsigned& nloc, unsigned& nx) {
  const unsigned G = gridDim.x * gridDim.y * gridDim.z;
  unsigned sum, cnt, mine, sp = 0u;
  for (;;) {
    sum = 0u; cnt = 0u; mine = 0u;
#pragma unroll
    for (unsigned j = 0; j < 16; ++j) { const unsigned c = xb_ld(&bar[XB_XCNT(j)]); sum += c; cnt += (c > 0u) ? 1u : 0u; mine = (j == x) ? c : mine; }
    if (sum == G) break;
    __builtin_amdgcn_s_sleep(1);
    if ((++sp & 255u) == 0u) { if (xb_ld(&bar[XB_TMO])) break; if (sp > XB_SPIN_CAP) { atomicAdd(&bar[XB_TMO], 1u); break; } }
  }
  nloc = mine > 0u ? mine : 1u; nx = cnt > 0u ? cnt : 1u;
}
DI void xcd_barrier(const XcdBarrier& b) {
  asm volatile("s_waitcnt vmcnt(0)" ::: "memory");
  __syncthreads();
  if (threadIdx.x == 0) {
    unsigned* bar = b.bar;
    __builtin_amdgcn_s_waitcnt(0);
    unsigned nloc = b.st[0], nx = b.st[1];
    if (nloc == 0u) { xcd_barrier_complete(bar, b.x, nloc, nx); b.st[0] = nloc; b.st[1] = nx; }
    const unsigned old = xb_add(&bar[XB_XSUB(b.x)], 1u);
    const unsigned gen = old / nloc;
    if (old + 1u == (gen + 1u) * nloc) {
      __builtin_amdgcn_fence(__ATOMIC_RELEASE, "agent");
      asm volatile("s_waitcnt vmcnt(0)" ::: "memory");
      const unsigned og = xb_add(&bar[XB_TOP], 1u);
      const unsigned tg = og / nx;
      if (og + 1u == (tg + 1u) * nx) xb_add(&bar[XB_TOPGEN], 1u);
      else XB_SPIN(xb_ld(&bar[XB_TOPGEN]) == tg, bar);
      __builtin_amdgcn_fence(__ATOMIC_ACQUIRE, "agent");
      xb_add(&bar[XB_XGEN(b.x)], 1u);
      asm volatile("s_waitcnt vmcnt(0)" ::: "memory");
    } else {
      XB_SPIN(xb_ld(&bar[XB_XGEN(b.x)]) == gen, bar);
      __builtin_amdgcn_fence(__ATOMIC_ACQUIRE, "agent");
      asm volatile("s_waitcnt vmcnt(0)" ::: "memory");
    }
  }
  __syncthreads();
}

constexpr int STEPS_PER_LAYER = 11, STEPS_PER_GROUP = 1 + DEPTH * STEPS_PER_LAYER, N_STEPS = 1 + NGROUP * STEPS_PER_GROUP;

DI void run_step(const Params& P, int step, bf16_t* lds) {
  int tid = threadIdx.x, bid = blockIdx.x, nb = gridDim.x;
  unsigned char* wsp = P.ws;
  asm volatile("" : "+v"(tid));
  asm volatile("" : "+s"(bid), "+s"(nb), "+s"(wsp));
  if (step == 0) {
    for (int it = bid; it < PREP_ITEMS; it += nb) prep_item(P, it, lds, tid);
    return;
  }
  step -= 1;
  Ctx c; c.p = &P; c.lds = lds; c.tid = tid; c.bid = bid; c.nb = nb; c.wsp = wsp;
  c.g = step / STEPS_PER_GROUP; int s = step - c.g * STEPS_PER_GROUP;
  if (s == 0) { c.l = 0; phase_xm0(c); return; }
  s -= 1; c.l = s / STEPS_PER_LAYER; s -= c.l * STEPS_PER_LAYER;
  const int l = c.l;
  switch (s) {
    case 0: phase_g1(c); break;
    case 1: phase_conv(c); gate_prepass(c); break;
    case 2: phase_g2(c); break;
    case 3: phase_mix(c); break;
    case 4: phase_post(c); break;
    case 5: phase_merge(c); break;
    case 6: phase_wout(c); break;
    case 7: phase_ln(c, (const bf16_t*)(wsp + OFF_R3 + 64 * MiB), c.xin(), c.in(I_LN1W) + l * 1024, c.in(I_LN1B) + l * 1024, l, 3, 4); break;
    case 8: phase_mlp1(c); break;
    case 9: phase_mlp2(c); break;
    case 10: phase_ln(c, (const bf16_t*)(wsp + OFF_R1 + 256 * MiB), c.xout(), c.in(I_LN2W) + l * 1024, c.in(I_LN2B) + l * 1024, (l + 1 < DEPTH) ? l + 1 : -1, 0, 1); break;
  }
}

__global__ void __launch_bounds__(NT) fwd_megakernel(Params P) {
  extern __shared__ __attribute__((aligned(16))) unsigned char smem[];
  bf16_t* lds = (bf16_t*)smem;
  cg::grid_group grid = cg::this_grid();
  volatile LAS unsigned* xst = (volatile LAS unsigned*)(LAS unsigned char*)(smem + LDS_WORK);
  if (threadIdx.x < 4) xst[threadIdx.x] = 0u;
  __syncthreads();
  const XcdBarrier xb = xcd_barrier_post((unsigned*)(P.ws + OFF_BAR), xst);
  for (int s = P.step_lo; s < P.step_hi; ++s) {
    run_step(P, s, lds);
#if REPEAT_MASK
    {
      int rs = -1;
      if (s == 0) rs = 12; else { int q = (s - 1) % STEPS_PER_GROUP; rs = (q == 0) ? 11 : (q - 1) % STEPS_PER_LAYER; }
      if ((REPEAT_MASK >> rs) & 1) { grid.sync(); run_step(P, s, lds); }
    }
#endif
#if EXTRA_SYNC
    grid.sync();
#endif
    if (s + 1 < P.step_hi) { if (s == 0) grid.sync(); else xcd_barrier(xb); }
  }
}

extern "C" void kernel_launch(void* const* d_in, const int* in_sizes, int n_in, void* d_out, int out_size, void* d_ws, size_t ws_size,
                              hipStream_t stream) {
  static int grid_blocks = 0;
  if (!grid_blocks) {
    int dev = 0, cus = 0, per_cu = 0;
    hipGetDevice(&dev);
    hipDeviceGetAttribute(&cus, hipDeviceAttributeMultiprocessorCount, dev);
    hipFuncSetAttribute((const void*)fwd_megakernel, hipFuncAttributeMaxDynamicSharedMemorySize, LDS_BYTES);
    hipOccupancyMaxActiveBlocksPerMultiprocessor(&per_cu, (const void*)fwd_megakernel, NT, LDS_BYTES);
    if (per_cu < 1) per_cu = 1;
    grid_blocks = cus * per_cu;
    if (ws_size < WS_END) fprintf(stderr, "workspace too small: %zu < %zu\n", ws_size, (size_t)WS_END);
  }
  Params p{};
  for (int i = 0; i < 31; ++i) p.in[i] = (const float*)d_in[i];
  p.out = (float*)d_out; p.ws = (unsigned char*)d_ws;
#if MULTI_LAUNCH
  for (int s = 0; s < N_STEPS; ++s) {
    p.step_lo = s; p.step_hi = s + 1;
    hipLaunchKernelGGL(fwd_megakernel, dim3(grid_blocks), dim3(NT), LDS_BYTES, stream, p);
  }
#else
  p.step_lo = 0; p.step_hi = N_STEPS;
  (void)hipMemsetAsync((char*)d_ws + OFF_BAR, 0, XCD_BAR_WORDS * sizeof(unsigned), stream);
  void* args[] = {&p};
  hipError_t e = hipLaunchCooperativeKernel((const void*)fwd_megakernel, dim3(grid_blocks), dim3(NT), args, LDS_BYTES, stream);
  if (e != hipSuccess) fprintf(stderr, "cooperative launch failed: %s (grid %d)\n", hipGetErrorString(e), grid_blocks);
#endif
}
```

```cpp
#include <hip/hip_runtime.h>
#include <hip/hip_cooperative_groups.h>
#include <cstdio>
namespace cg = cooperative_groups;

typedef unsigned short bf16_t;
using bf16x8 = __attribute__((ext_vector_type(8))) short;
using f32x16 = __attribute__((ext_vector_type(16))) float;
#define DI __device__ __forceinline__
#define MFMA(a, b, c) __builtin_amdgcn_mfma_f32_32x32x16_bf16((a), (b), (c), 0, 0, 0)

#ifndef MULTI_LAUNCH
#define MULTI_LAUNCH 0
#endif
#ifndef REPEAT_MASK
#define REPEAT_MASK 0
#ifndef REPEAT_ATT
#define REPEAT_ATT 0
#endif
#ifndef REPEAT_SCAN
#define REPEAT_SCAN 0
#endif
#endif
#ifndef PROBE_EPI2
#define PROBE_EPI2 0
#endif
#ifndef EXTRA_SYNC
#define EXTRA_SYNC 0
#endif

constexpr int NT = 512;
constexpr int SEQ = 2048, D = 1024;
constexpr int GSEQ = 16;
constexpr int TG = GSEQ * SEQ;
constexpr int NGROUP = 3;
constexpr int NSEQ_ALL = 48;
constexpr int DEPTH = 2;
constexpr int N_IN = 6928, N_INP = 7168;
constexpr int LDP = 6912;
constexpr int P_XM = 0, P_Z = 1024, P_AQ = 2048, P_AK = 2560, P_AV = 2688, P_U = 2816, P_V = 3328, P_G = 3840;
constexpr float ALPHA = 1.4142135623730951f;
constexpr float LN_EPS = 1e-5f;

enum { I_XP = 0, I_XS, I_CP, I_CS, I_ADAW, I_ADAB, I_WIN, I_BIN, I_CONVW, I_CONVB, I_WQ, I_WK, I_WV, I_NORMW, I_SINK,
       I_CLNW, I_CLNB, I_CWS, I_CBS, I_PM, I_PA, I_PC, I_WOUT, I_LN1W, I_LN1B, I_W1, I_B1, I_W2, I_B2, I_LN2W, I_LN2B };

constexpr size_t W_IN = 0, W_QKV = 7340032, W_PM = 8126464, W_PA = 9175040  , W_PC = W_PA + 512, W_OUT = 10223616,
                 W_1 = 11272192, W_2 = 15466496, W_LAYER = 19660800;
constexpr size_t MiB = 1u << 20;
constexpr size_t OFF_W = 0;
constexpr size_t OFF_MOD = 80 * MiB;
constexpr size_t OFF_BINP = 83 * MiB;
constexpr size_t OFF_R0 = 84 * MiB;
constexpr size_t OFF_R2 = 148 * MiB;
constexpr size_t OFF_R1 = 212 * MiB;
constexpr size_t OFF_R3 = 644 * MiB;
constexpr size_t OFF_R5 = 900 * MiB;
constexpr size_t OFF_GATES = 964 * MiB;
constexpr size_t OFF_GPRE = 966 * MiB;
constexpr size_t OFF_BAR = 970 * MiB;
constexpr size_t WS_END = 971 * MiB;

constexpr int LDS_WORK = 150 * 1024;
constexpr int LDS_BYTES = LDS_WORK + 64;

struct Params {
  const float* in[31];
  float* out;
  unsigned char* ws;
  int step_lo, step_hi;
};

typedef __bf16 bf2_t __attribute__((ext_vector_type(2)));
typedef float f2_t __attribute__((ext_vector_type(2)));
DI bf16_t f2bf(float x) { return __builtin_bit_cast(unsigned short, (__bf16)x); }
DI float bf2f(bf16_t b) { return __uint_as_float(((unsigned)b) << 16); }
DI unsigned pack2(float a, float b) { f2_t v = {a, b}; return __builtin_bit_cast(unsigned, __builtin_convertvector(v, bf2_t)); }
DI float lo2f(unsigned u) { return __uint_as_float(u << 16); }
DI float hi2f(unsigned u) { return __uint_as_float(u & 0xffff0000u); }
DI int crow(int e, int h) { return (e & 3) + 8 * (e >> 2) + 4 * h; }
DI float sigmoidf_(float x) { return __builtin_amdgcn_rcpf(1.f + __builtin_amdgcn_exp2f(-1.4426950408889634f * x)); }
DI float gelu_tanh(float x) {
  const float u2 = 1.5957691216057308f * (x + 0.044715f * x * x * x);
  return x * __builtin_amdgcn_rcpf(1.f + __builtin_amdgcn_exp2f(-1.4426950408889634f * u2));
}
template <int M> DI float sx(float v) { return __int_as_float(__builtin_amdgcn_ds_swizzle(__float_as_int(v), (M << 10) | 0x1F)); }
DI float bperm(int src_lane, float v) { return __int_as_float(__builtin_amdgcn_ds_bpermute(src_lane << 2, __float_as_int(v))); }
DI float wsum(float v, int lane) { v += sx<1>(v); v += sx<2>(v); v += sx<4>(v); v += sx<8>(v); v += sx<16>(v); v += bperm(lane ^ 32, v); return v; }

#define LAS __attribute__((address_space(3)))
using f32x4 = __attribute__((ext_vector_type(4))) float;
constexpr int GBK = 64, GHALF = 128, HTB = GHALF * GBK * 2;
DI int lds_byte(int r, int c) { const int st = (r >> 4) * 2 + (c >> 5), rr = r & 15, cc = c & 31, ob = rr * 64 + cc * 2; return st * 1024 + (ob ^ (((ob >> 9) & 1) << 5)); }
DI void stage_rc(int b, int& R, int& C) { const int st = b / 1024, sb = b % 1024, swz = sb ^ (((sb >> 9) & 1) << 5); R = (st >> 1) * 16 + swz / 64; C = (st & 1) * 32 + (swz % 64) / 2; }
DI int perm32(int rho) { const int n = rho >> 4, i = rho & 15; return 8 * (i >> 2) + 4 * n + (i & 3); }
struct GUnit { const char* A; const char* B; int nt, pm, pn, tag; };
typedef f32x4 GAcc[2][2][4][2];

DI void static_unit(int L, int nM, int nN, int& pm, int& pn) {
  const int nwg = nM * nN;
  int wgid = L; { const int q = nwg / 8, r = nwg % 8, xcd = wgid % 8, off = wgid / 8; wgid = (xcd < r ? xcd * (q + 1) : r * (q + 1) + (xcd - r) * q) + off; }
  const int nig = 8 * nN, gid = wgid / nig, fm = gid * 8, gsz = (nM - fm) < 8 ? (nM - fm) : 8;
  pm = fm + ((wgid % nig) % gsz); pn = (wgid % nig) / gsz;
}

template <class Sched, class Epi>
DI void gemm_phase8(bf16_t* lds_generic, int lda, int ldb, const Sched& S, const Epi& E, int tid) {
  LAS unsigned char* lds = (LAS unsigned char*)lds_generic;
  const int wid = __builtin_amdgcn_readfirstlane(tid >> 6), lane = tid & 63, wr = wid >> 2, wc = wid & 3, fr = lane & 15, fq = lane >> 4;
  unsigned voffA[2], voffB[2];
#pragma unroll
  for (int i = 0; i < 2; ++i) { int R, C; stage_rc(tid * 16 + i * 8192, R, C); const int Rb = (R & ~31) + perm32(R & 31);
    voffA[i] = (unsigned)(R * lda + C) * 2u; voffB[i] = (unsigned)(Rb * ldb + C) * 2u; }
  const size_t kstep = (size_t)(GBK * 2);
  const size_t hstepA = (size_t)GHALF * lda * 2, hstepB = (size_t)GHALF * ldb * 2;
  const unsigned ldsw = (unsigned)wid * 1024u;
  const int aoff = lds_byte(wr * 64 + fr, fq * 8), boff = lds_byte(wc * 32 + fr, fq * 8);
#define PG8_SA(b, h) (((b) * 2 + (h)) * HTB)
#define PG8_SB(b, h) ((4 + (b) * 2 + (h)) * HTB)
#define PG8_STAGE(bufoff, gbase, voff) do { _Pragma("unroll") for (int _i = 0; _i < 2; ++_i) \
    __builtin_amdgcn_global_load_lds((const unsigned*)((const char*)(gbase) + (voff)[_i]), (LAS unsigned*)(lds + (bufoff) + ldsw + _i * 8192), 16, 0, 0); } while (0)
#define PG8_LDA(dst, b, h) do { _Pragma("unroll") for (int m = 0; m < 4; ++m) _Pragma("unroll") for (int k = 0; k < 2; ++k) dst[m][k] = *(const LAS bf16x8*)(lds + PG8_SA(b, h) + aoff + m * 2048 + k * 1024); } while (0)
#define PG8_LDB(dst, b, h) do { _Pragma("unroll") for (int n = 0; n < 2; ++n) _Pragma("unroll") for (int k = 0; k < 2; ++k) dst[n][k] = *(const LAS bf16x8*)(lds + PG8_SB(b, h) + boff + n * 2048 + k * 1024); } while (0)
#define PG8_MMA(ai, bj, At, Bt) do { __builtin_amdgcn_s_setprio(1); _Pragma("unroll") for (int m = 0; m < 4; ++m) _Pragma("unroll") for (int n = 0; n < 2; ++n) _Pragma("unroll") for (int k = 0; k < 2; ++k) \
    acc[ai][bj][m][n] = __builtin_amdgcn_mfma_f32_16x16x32_bf16(Bt[n][k], At[m][k], acc[ai][bj][m][n], 0, 0, 0); __builtin_amdgcn_s_setprio(0); } while (0)
#define PG8_WAIT_V(n) asm volatile("s_waitcnt vmcnt(" #n ")" ::: "memory")
#define PG8_WAIT_L(n) asm volatile("s_waitcnt lgkmcnt(" #n ")" ::: "memory")
#define PG8_BAR __builtin_amdgcn_s_barrier()
#define PG8_SCHED __builtin_amdgcn_sched_barrier(0)
  GUnit cur, nxt; int ui = 0;
  if (!S(0, cur)) return;
  GAcc acc;
#pragma unroll
  for (int a = 0; a < 2; ++a)
#pragma unroll
    for (int b = 0; b < 2; ++b)
#pragma unroll
      for (int m = 0; m < 4; ++m)
#pragma unroll
        for (int n = 0; n < 2; ++n) acc[a][b][m][n] = (f32x4){0.f, 0.f, 0.f, 0.f};
  bf16x8 At[4][2], B0[2][2], B1[2][2];
  const char* cA = cur.A; const char* cB = cur.B;
  PG8_STAGE(PG8_SB(0, 0), cB, voffB); PG8_STAGE(PG8_SA(0, 0), cA, voffA); PG8_STAGE(PG8_SB(0, 1), cB + hstepB, voffB); PG8_STAGE(PG8_SA(0, 1), cA + hstepA, voffA);
  if (wr == 1) PG8_BAR;
  PG8_WAIT_V(4); PG8_BAR;
  PG8_STAGE(PG8_SB(1, 0), cB + kstep, voffB); PG8_STAGE(PG8_SA(1, 0), cA + kstep, voffA); PG8_STAGE(PG8_SB(1, 1), cB + hstepB + kstep, voffB);
  PG8_WAIT_V(6); PG8_BAR;
  for (;;) {
    const bool has_next = S(ui + 1, nxt);
    const char* nA = has_next ? nxt.A : cA; const char* nB = has_next ? nxt.B : cB;
    const int nt = cur.nt;
#pragma unroll 1
    for (int t = 0; t < nt; t += 2) {
      const bool last = (t == nt - 2);
      const char* a1 = cA + (size_t)(t + 1) * kstep;
      const char* a2 = last ? nA : cA + (size_t)(t + 2) * kstep; const char* b2 = last ? nB : cB + (size_t)(t + 2) * kstep;
      const char* a3 = a2 + kstep; const char* b3 = b2 + kstep;
      PG8_LDB(B0, 0, 0); PG8_SCHED; PG8_LDA(At, 0, 0); PG8_STAGE(PG8_SA(1, 1), a1 + hstepA, voffA);
      PG8_WAIT_L(8); PG8_BAR; PG8_WAIT_L(0); PG8_MMA(0, 0, At, B0); PG8_BAR; PG8_SCHED;
      PG8_LDB(B1, 0, 1); PG8_STAGE(PG8_SB(0, 0), b2, voffB);
      PG8_BAR; PG8_WAIT_L(0); PG8_MMA(0, 1, At, B1); PG8_BAR;
      PG8_LDA(At, 0, 1); PG8_STAGE(PG8_SA(0, 0), a2, voffA);
      PG8_BAR; PG8_WAIT_L(0); PG8_MMA(1, 0, At, B0); PG8_BAR; PG8_SCHED;
      PG8_STAGE(PG8_SB(0, 1), b2 + hstepB, voffB);
      PG8_WAIT_V(6); PG8_BAR; PG8_MMA(1, 1, At, B1); PG8_BAR;
      PG8_LDB(B0, 1, 0); PG8_SCHED; PG8_LDA(At, 1, 0); PG8_STAGE(PG8_SA(0, 1), a2 + hstepA, voffA);
      PG8_WAIT_L(8); PG8_BAR; PG8_WAIT_L(0); PG8_MMA(0, 0, At, B0); PG8_BAR; PG8_SCHED;
      PG8_LDB(B1, 1, 1); PG8_STAGE(PG8_SB(1, 0), b3, voffB);
      PG8_BAR; PG8_WAIT_L(0); PG8_MMA(0, 1, At, B1); PG8_BAR;
      PG8_LDA(At, 1, 1); PG8_STAGE(PG8_SA(1, 0), a3, voffA);
      PG8_BAR; PG8_WAIT_L(0); PG8_MMA(1, 0, At, B0); PG8_BAR; PG8_SCHED;
      PG8_STAGE(PG8_SB(1, 1), b3 + hstepB, voffB);
      PG8_WAIT_V(6); PG8_BAR; PG8_MMA(1, 1, At, B1); PG8_BAR;
    }
    const bool keep = E(acc, cur, wr, wc, fr, fq);
#if PROBE_EPI2
    if (!keep) E(acc, cur, wr, wc, fr, fq);
#endif
    if (!has_next) break;
    if (!keep)
#pragma unroll
    for (int a = 0; a < 2; ++a)
#pragma unroll
      for (int b = 0; b < 2; ++b)
#pragma unroll
        for (int m = 0; m < 4; ++m)
#pragma unroll
          for (int n = 0; n < 2; ++n) acc[a][b][m][n] = (f32x4){0.f, 0.f, 0.f, 0.f};
    cur = nxt; cA = nA; cB = nB; ++ui;
  }
  PG8_WAIT_V(0);
  if (wr == 0) PG8_BAR;
  PG8_BAR;
#undef PG8_SA
#undef PG8_SB
#undef PG8_STAGE
#undef PG8_LDA
#undef PG8_LDB
#undef PG8_MMA
#undef PG8_WAIT_V
#undef PG8_WAIT_L
#undef PG8_BAR
#undef PG8_SCHED
}

template <class F> DI void for_rows8(const GAcc& acc, int wr, int wc, int fr, int fq, F f) {
#pragma unroll
  for (int ai = 0; ai < 2; ++ai)
#pragma unroll
    for (int m = 0; m < 4; ++m)
#pragma unroll
      for (int bj = 0; bj < 2; ++bj) f(ai * 128 + wr * 64 + m * 16 + fr, bj * 128 + wc * 32 + 8 * fq, acc[ai][bj][m][0], acc[ai][bj][m][1]);
}
template <class F> DI void for_rows8b(const GAcc& acc, int wr, int wc, int fr, int fq, F f) {
#pragma unroll
  for (int ai = 0; ai < 2; ++ai)
#pragma unroll
    for (int m = 0; m < 4; ++m)
#pragma unroll
      for (int bj = 0; bj < 2; ++bj) f(ai * 128 + wr * 64 + m * 16 + fr, bj * 128 + wc * 32 + 8 * fq, bj, acc[ai][bj][m][0], acc[ai][bj][m][1]);
}
struct ColVec { f32x4 v[2][2]; };
DI ColVec load_cols(const float* p, int wc, int fq) {
  ColVec c;
#pragma unroll
  for (int bj = 0; bj < 2; ++bj)
#pragma unroll
    for (int n = 0; n < 2; ++n) c.v[bj][n] = *(const f32x4*)(p + bj * 128 + wc * 32 + 8 * fq + 4 * n);
  return c;
}
DI uint4 pack8(f32x4 a, f32x4 b) { uint4 o; o.x = pack2(a[0], a[1]); o.y = pack2(a[2], a[3]); o.z = pack2(b[0], b[1]); o.w = pack2(b[2], b[3]); return o; }

struct Ctx {
  const Params* p;
  int g, l;
  int tid, bid, nb;
  unsigned char* wsp;
  bf16_t* lds;
  DI const float* in(int i) const { int ii = i; asm volatile("" : "+s"(ii)); return p->in[ii]; }
  DI unsigned char* ws() const { return wsp; }
  DI const bf16_t* W(size_t off) const { return (const bf16_t*)(wsp + OFF_W) + (size_t)l * W_LAYER + off; }
  DI const float* mod(int which, int seq_local) const {
    return (const float*)(wsp + OFF_MOD) + ((size_t)(l * NSEQ_ALL + g * GSEQ + seq_local)) * 6144 + which * 1024;
  }
  DI const float* xin() const {
    if (l == 0) return (g < 2) ? in(I_XP) + (size_t)g * TG * D : in(I_XS);
    return p->out + (size_t)g * TG * D;
  }
  DI float* xout() const { return p->out + (size_t)g * TG * D; }
};

DI void transpose_tile(const float* __restrict__ src, int ldsrc, int k0, int srccol0, int nvalid, bf16_t* __restrict__ dst, int lddst,
                       int n0, float scale, float* lds, int tid) {
  {
    const int n = tid & 63, kk = tid >> 6;
#pragma unroll
    for (int i = 0; i < 8; ++i) {
      const int k = kk + 8 * i;
      lds[k * 65 + n] = (n < nvalid) ? src[(size_t)(k0 + k) * ldsrc + srccol0 + n] : 0.f;
    }
  }
  __syncthreads();
  {
    const int k = tid & 63, nn = tid >> 6;
#pragma unroll
    for (int i = 0; i < 8; ++i) {
      const int n = nn + 8 * i;
      dst[(size_t)(n0 + n) * lddst + k0 + k] = f2bf(lds[k * 65 + n] * scale);
    }
  }
  __syncthreads();
}

DI void prep_item(const Params& P, int item, bf16_t* ldsb, int tid) {
  float* lds = (float*)ldsb;
  constexpr int PER_LAYER = 4800;
  if (item < 2 * PER_LAYER) {
    const int l = item / PER_LAYER; int it = item - l * PER_LAYER;
    bf16_t* wb = (bf16_t*)(P.ws + OFF_W) + (size_t)l * W_LAYER;
    if (it < 1792) {
      const int ntile = it >> 4, kt = it & 15;
      const int n0 = ntile * 64;
      int srccol0, nvalid;
      if (n0 < 2048) { srccol0 = n0; nvalid = 64; }
      else if (n0 < 6912) { srccol0 = n0 + 16; nvalid = 64; }
      else if (n0 == 6912) { srccol0 = 2048; nvalid = 16; }
      else { srccol0 = 0; nvalid = 0; }
      transpose_tile(P.in[I_WIN] + (size_t)l * 1024 * N_IN, N_IN, kt * 64, srccol0, nvalid, wb + W_IN, 1024, n0, 1.f, lds, tid);
      return;
    }
    it -= 1792;
    if (it < 192) {
      const int mh = it >> 4, tt = it & 15;
      const int which = mh >> 2, head = mh & 3;
      const float* src = P.in[I_WQ + which] + ((size_t)(l * 4 + head)) * 65536;
      transpose_tile(src, 256, (tt & 3) * 64, (tt >> 2) * 64, 64, wb + W_QKV + (size_t)mh * 65536, 256, (tt >> 2) * 64,
                     which == 1 ? 0.0625f : 1.f, lds, tid);
      return;
    }
    it -= 192;
    if (it < 256) { transpose_tile(P.in[I_PM] + (size_t)l * 1024 * 1024, 1024, (it & 15) * 64, (it >> 4) * 64, 64, wb + W_PM, 1024, (it >> 4) * 64, 1.f, lds, tid); return; }
    it -= 256;
    if (it < 128) { transpose_tile(P.in[I_PA] + (size_t)l * 512 * 1024, 1024, (it & 7) * 64, (it >> 3) * 64, 64, wb + W_PA, 1024, (it >> 3) * 64, 1.f, lds, tid); return; }
    it -= 128;
    if (it < 128) { transpose_tile(P.in[I_PC] + (size_t)l * 512 * 1024, 1024, (it & 7) * 64, (it >> 3) * 64, 64, wb + W_PC, 1024, (it >> 3) * 64, 1.f, lds, tid); return; }
    it -= 128;
    if (it < 256) { transpose_tile(P.in[I_WOUT] + (size_t)l * 1024 * 1024, 1024, (it & 15) * 64, (it >> 4) * 64, 64, wb + W_OUT, 1024, (it >> 4) * 64, 1.f, lds, tid); return; }
    it -= 256;
    if (it < 1024) { transpose_tile(P.in[I_W1] + (size_t)l * 1024 * 4096, 4096, (it & 15) * 64, (it >> 4) * 64, 64, wb + W_1, 1024, (it >> 4) * 64, 1.f, lds, tid); return; }
    it -= 1024;
    transpose_tile(P.in[I_W2] + (size_t)l * 4096 * 1024, 1024, (it & 63) * 64, (it >> 6) * 64, 64, wb + W_2, 4096, (it >> 6) * 64, 1.f, lds, tid);
    return;
  }
  item -= 2 * PER_LAYER;
  if (item < 2) {
    const int l = item;
    float* bp = (float*)(P.ws + OFF_BINP) + l * N_INP;
    const float* b = P.in[I_BIN] + (size_t)l * N_IN;
    for (int n = tid; n < N_INP; n += NT) {
      float v = 0.f;
      if (n < 2048) v = b[n]; else if (n < 6912) v = b[n + 16]; else if (n < 6928) v = b[2048 + n - 6912];
      bp[n] = v;
    }
    return;
  }
  item -= 2;
  {
    const int bh = item & 1, cc = (item >> 1) % 48, l = item / 96;
    for (int idx = tid; idx < 1024 * 24; idx += NT) {
      const int k = idx / 24, b = idx - k * 24, bg = bh * 24 + b;
      const float c = (bg < 32) ? P.in[I_CP][bg * 1024 + k] : P.in[I_CS][(bg - 32) * 1024 + k];
      lds[idx] = c / (1.f + __expf(-c));
    }
    __syncthreads();
    const int cl = tid & 127, kq = tid >> 7, col = cc * 128 + cl;
    float acc[24];
#pragma unroll
    for (int b = 0; b < 24; ++b) acc[b] = 0.f;
    const float* w = P.in[I_ADAW] + (size_t)l * 1024 * 6144 + col;
    for (int k = kq * 256; k < kq * 256 + 256; ++k) {
      const float wv = w[(size_t)k * 6144];
      const float4* s4 = (const float4*)(lds + k * 24);
#pragma unroll
      for (int q = 0; q < 6; ++q) {
        const float4 s = s4[q];
        acc[4 * q] += wv * s.x; acc[4 * q + 1] += wv * s.y; acc[4 * q + 2] += wv * s.z; acc[4 * q + 3] += wv * s.w;
      }
    }
    __syncthreads();
#pragma unroll
    for (int b = 0; b < 24; ++b) lds[(kq * 24 + b) * 128 + cl] = acc[b];
    __syncthreads();
    float* mod = (float*)(P.ws + OFF_MOD);
    for (int idx = tid; idx < 24 * 128; idx += NT) {
      const int b = idx >> 7, c = idx & 127;
      const float v = lds[(0 * 24 + b) * 128 + c] + lds[(1 * 24 + b) * 128 + c] + lds[(2 * 24 + b) * 128 + c] + lds[(3 * 24 + b) * 128 + c] +
                      P.in[I_ADAB][l * 6144 + cc * 128 + c];
      mod[((size_t)(l * NSEQ_ALL + bh * 24 + b)) * 6144 + cc * 128 + c] = v;
    }
    __syncthreads();
  }
}
constexpr int PREP_ITEMS = 2 * 4800 + 2 + 192;

DI void phase_xm0(const Ctx& c) {
  const float* x = c.xin();
  bf16_t* xm = (bf16_t*)(c.ws() + OFF_R0);
  const size_t n8 = (size_t)TG * D / 8;
  for (size_t i = (size_t)c.bid * NT + c.tid; i < n8; i += (size_t)c.nb * NT) {
    const int row = (int)(i >> 7), col = (int)(i & 127) * 8;
    const float4 v0 = *(const float4*)(x + i * 8), v1 = *(const float4*)(x + i * 8 + 4);
    const float* scp = c.mod(1, row >> 11) + col; const float* shp = c.mod(0, row >> 11) + col;
    const float4 sc0 = *(const float4*)scp, sc1 = *(const float4*)(scp + 4), sh0 = *(const float4*)shp, sh1 = *(const float4*)(shp + 4);
    uint4 o;
    o.x = pack2(v0.x * (1.f + sc0.x) + sh0.x, v0.y * (1.f + sc0.y) + sh0.y); o.y = pack2(v0.z * (1.f + sc0.z) + sh0.z, v0.w * (1.f + sc0.w) + sh0.w);
    o.z = pack2(v1.x * (1.f + sc1.x) + sh1.x, v1.y * (1.f + sc1.y) + sh1.y); o.w = pack2(v1.z * (1.f + sc1.z) + sh1.z, v1.w * (1.f + sc1.w) + sh1.w);
    *(uint4*)(xm + i * 8) = o;
  }
}

DI void phase_conv(const Ctx& c) {
  const bf16_t* proj = (const bf16_t*)(c.ws() + OFF_R1);
  bf16_t* xc = (bf16_t*)(c.ws() + OFF_R2);
  float* wl = (float*)c.lds;
  for (int i = c.tid; i < 6 * 1024; i += NT) wl[i] = (i < 5120) ? c.in(I_CONVW)[(size_t)c.l * 5120 + i] : c.in(I_CONVB)[(size_t)c.l * 1024 + i - 5120];
  __syncthreads();
  const size_t n16 = (size_t)TG * 64, stride = (size_t)c.nb * NT;
  const int ch = (c.tid & 63) * 16;
  size_t i = (size_t)c.bid * NT + c.tid;
  uint4 v[5][2], nv[5][2];
  auto load_rows = [&](size_t idx, uint4 (&dst)[5][2]) {
    const int row = (int)(idx >> 6), s = row & (SEQ - 1);
#pragma unroll
    for (int tp = 0; tp < 5; ++tp) {
      const int ss = s + tp - 2;
      if (ss >= 0 && ss < SEQ) {
        const bf16_t* p = proj + (size_t)(row + tp - 2) * LDP + P_XM + ch;
        dst[tp][0] = *(const uint4*)p; dst[tp][1] = *(const uint4*)(p + 8);
      } else { dst[tp][0] = make_uint4(0, 0, 0, 0); dst[tp][1] = make_uint4(0, 0, 0, 0); }
    }
  };
  if (i < n16) load_rows(i, v);
  for (; i < n16; i += stride) {
    const int row = (int)(i >> 6);
    const bool more = i + stride < n16;
    if (more) load_rows(i + stride, nv);
    uint4 o[2];
#pragma unroll
    for (int hh = 0; hh < 2; ++hh) {
      float acc[8];
      const int c0 = ch + hh * 8;
      const float4 cb0 = *(const float4*)(wl + 5120 + c0), cb1 = *(const float4*)(wl + 5120 + c0 + 4);
      acc[0] = cb0.x; acc[1] = cb0.y; acc[2] = cb0.z; acc[3] = cb0.w; acc[4] = cb1.x; acc[5] = cb1.y; acc[6] = cb1.z; acc[7] = cb1.w;
#pragma unroll
      for (int tp = 0; tp < 5; ++tp) {
        const uint4 u = v[tp][hh];
        const float4 w0 = *(const float4*)(wl + tp * 1024 + c0), w1 = *(const float4*)(wl + tp * 1024 + c0 + 4);
        acc[0] += lo2f(u.x) * w0.x; acc[1] += hi2f(u.x) * w0.y; acc[2] += lo2f(u.y) * w0.z; acc[3] += hi2f(u.y) * w0.w;
        acc[4] += lo2f(u.z) * w1.x; acc[5] += hi2f(u.z) * w1.y; acc[6] += lo2f(u.w) * w1.z; acc[7] += hi2f(u.w) * w1.w;
      }
#pragma unroll
      for (int j = 0; j < 8; ++j) acc[j] = acc[j] * sigmoidf_(acc[j]);
      o[hh].x = pack2(acc[0], acc[1]); o[hh].y = pack2(acc[2], acc[3]); o[hh].z = pack2(acc[4], acc[5]); o[hh].w = pack2(acc[6], acc[7]);
    }
    *(uint4*)(xc + (size_t)row * 1024 + ch) = o[0]; *(uint4*)(xc + (size_t)row * 1024 + ch + 8) = o[1];
    if (more) {
#pragma unroll
      for (int tp = 0; tp < 5; ++tp) { v[tp][0] = nv[tp][0]; v[tp][1] = nv[tp][1]; }
    }
  }
  __syncthreads();
}

DI void phase_post(const Ctx& c) {
  const bf16_t* hf = (const bf16_t*)(c.ws() + OFF_R0);
  bf16_t* hb = (bf16_t*)(c.ws() + OFF_R2);
  const bf16_t* proj = (const bf16_t*)(c.ws() + OFF_R1);
  const float* nw = c.in(I_NORMW) + (size_t)c.l * 1024;
  const int lane = c.tid & 63;
  const int gw = c.bid * (NT / 64) + (c.tid >> 6), nw_ = c.nb * (NT / 64);
  float4 wv[4];
#pragma unroll
  for (int hd = 0; hd < 4; ++hd) wv[hd] = *(const float4*)(nw + hd * 256 + lane * 4);
  for (int idx0 = gw * 4; idx0 < TG * 4; idx0 += nw_ * 4) {
    uint2 a[4], b[4], z[4];
#pragma unroll
    for (int rr = 0; rr < 4; ++rr) {
      const int row = (idx0 + rr) >> 2, head = (idx0 + rr) & 3;
      const size_t base = (size_t)row * 1024 + head * 256 + lane * 4;
      a[rr] = *(const uint2*)(hf + base); b[rr] = *(const uint2*)(hb + base);
      z[rr] = *(const uint2*)(proj + (size_t)row * LDP + P_Z + head * 256 + lane * 4);
    }
#pragma unroll
    for (int rr = 0; rr < 4; ++rr) {
      const int row = (idx0 + rr) >> 2, head = (idx0 + rr) & 3;
      const size_t base = (size_t)row * 1024 + head * 256 + lane * 4;
      float x0 = lo2f(a[rr].x) + lo2f(b[rr].x), x1 = hi2f(a[rr].x) + hi2f(b[rr].x), x2 = lo2f(a[rr].y) + lo2f(b[rr].y), x3 = hi2f(a[rr].y) + hi2f(b[rr].y);
      const float mean = wsum(x0 + x1 + x2 + x3, lane) * (1.f / 256.f);
      x0 -= mean; x1 -= mean; x2 -= mean; x3 -= mean;
      const float var = wsum(x0 * x0 + x1 * x1 + x2 * x2 + x3 * x3, lane) * (1.f / 256.f);
      const float rstd = rsqrtf(var + LN_EPS);
      const float4 w = wv[rr];
      uint2 o;
      o.x = pack2(x0 * rstd * w.x * sigmoidf_(lo2f(z[rr].x)), x1 * rstd * w.y * sigmoidf_(hi2f(z[rr].x)));
      o.y = pack2(x2 * rstd * w.z * sigmoidf_(lo2f(z[rr].y)), x3 * rstd * w.w * sigmoidf_(hi2f(z[rr].y)));
      *(uint2*)(hb + base) = o;
    }
  }
}

DI void phase_ln(const Ctx& c, const bf16_t* pre, const float* xres, const float* w, const float* b, int mod_layer, int mod_sh, int mod_sc) {
  float* xo = c.xout();
  bf16_t* xm = (bf16_t*)(c.ws() + OFF_R0);
  const int lane = c.tid & 63;
  const int gw = c.bid * (NT / 64) + (c.tid >> 6), nw_ = c.nb * (NT / 64);
  float4 ww[4], bb[4];
#pragma unroll
  for (int i = 0; i < 4; ++i) { ww[i] = *(const float4*)(w + i * 256 + lane * 4); bb[i] = *(const float4*)(b + i * 256 + lane * 4); }
  for (int row0 = gw * 4; row0 < TG; row0 += nw_ * 4) {
    float4 v[4][4], sc[4], sh[4];
    const float* modbase = (const float*)(c.ws() + OFF_MOD) + ((size_t)((mod_layer < 0 ? 0 : mod_layer) * NSEQ_ALL + c.g * GSEQ + (row0 >> 11))) * 6144;
#pragma unroll
    for (int rr = 0; rr < 4; ++rr)
#pragma unroll
      for (int i = 0; i < 4; ++i) {
        const size_t off = (size_t)(row0 + rr) * 1024 + i * 256 + lane * 4;
        const uint2 pv = *(const uint2*)(pre + off); const float4 xv = *(const float4*)(xres + off);
        v[rr][i].x = ALPHA * xv.x + lo2f(pv.x); v[rr][i].y = ALPHA * xv.y + hi2f(pv.x); v[rr][i].z = ALPHA * xv.z + lo2f(pv.y); v[rr][i].w = ALPHA * xv.w + hi2f(pv.y);
      }
    if (mod_layer >= 0) {
#pragma unroll
      for (int i = 0; i < 4; ++i) { sc[i] = *(const float4*)(modbase + mod_sc * 1024 + i * 256 + lane * 4); sh[i] = *(const float4*)(modbase + mod_sh * 1024 + i * 256 + lane * 4); }
    }
#pragma unroll
    for (int rr = 0; rr < 4; ++rr) {
      float s = 0.f;
#pragma unroll
      for (int i = 0; i < 4; ++i) s += v[rr][i].x + v[rr][i].y + v[rr][i].z + v[rr][i].w;
      const float mean = wsum(s, lane) * (1.f / 1024.f);
      float q = 0.f;
#pragma unroll
      for (int i = 0; i < 4; ++i) { float4& t = v[rr][i]; t.x -= mean; t.y -= mean; t.z -= mean; t.w -= mean; q += t.x * t.x + t.y * t.y + t.z * t.z + t.w * t.w; }
      const float rstd = rsqrtf(wsum(q, lane) * (1.f / 1024.f) + LN_EPS);
#pragma unroll
      for (int i = 0; i < 4; ++i) {
        float4& t = v[rr][i];
        t.x = t.x * rstd * ww[i].x + bb[i].x; t.y = t.y * rstd * ww[i].y + bb[i].y; t.z = t.z * rstd * ww[i].z + bb[i].z; t.w = t.w * rstd * ww[i].w + bb[i].w;
      }
    }
    asm volatile("" ::: "memory");
#pragma unroll
    for (int rr = 0; rr < 4; ++rr)
#pragma unroll
      for (int i = 0; i < 4; ++i) {
        const size_t off = (size_t)(row0 + rr) * 1024 + i * 256 + lane * 4;
        const float4 y = v[rr][i];
        *(float4*)(xo + off) = y;
        if (mod_layer >= 0) {
          uint2 o; o.x = pack2(y.x * (1.f + sc[i].x) + sh[i].x, y.y * (1.f + sc[i].y) + sh[i].y); o.y = pack2(y.z * (1.f + sc[i].z) + sh[i].z, y.w * (1.f + sc[i].w) + sh[i].w);
          *(uint2*)(xm + off) = o;
        }
      }
  }
}

DI void phase_g1(const Ctx& c) {
  const char* xm = (const char*)(c.ws() + OFF_R0);
  bf16_t* proj = (bf16_t*)(c.ws() + OFF_R1);
  float* gates = (float*)(c.ws() + OFF_GATES);
  const float* binp = (const float*)(c.ws() + OFF_BINP) + c.l * N_INP;
  const char* wt = (const char*)c.W(W_IN);
  constexpr int nM = TG / 256, nN = N_INP / 256;
  auto sched = [&](int i, GUnit& u) -> bool {
    const int L = i * c.nb + c.bid; if (L >= nM * nN) return false;
    static_unit(L, nM, nN, u.pm, u.pn);
    u.A = xm + (size_t)u.pm * 256 * 1024 * 2; u.B = wt + (size_t)u.pn * 256 * 1024 * 2; u.nt = 16; u.tag = 0; return true; };
  auto epi = [&](GAcc& acc, const GUnit& u, int wr, int wc, int fr, int fq) -> bool {
    const int m0 = u.pm * 256, n0 = u.pn * 256;
    const ColVec bv = load_cols(binp + n0, wc, fq);
    if (n0 < P_U) {
      for_rows8b(acc, wr, wc, fr, fq, [&](int rl, int cl, int bj, f32x4 v0, f32x4 v1) {
        *(uint4*)(proj + (size_t)(m0 + rl) * LDP + n0 + cl) = pack8(v0 + bv.v[bj][0], v1 + bv.v[bj][1]); });
    } else if (n0 < P_G) {
      for_rows8b(acc, wr, wc, fr, fq, [&](int rl, int cl, int bj, f32x4 v0, f32x4 v1) {
        v0 += bv.v[bj][0]; v1 += bv.v[bj][1];
#pragma unroll
        for (int j = 0; j < 4; ++j) { v0[j] = gelu_tanh(v0[j]); v1[j] = gelu_tanh(v1[j]); }
        *(uint4*)(proj + (size_t)(m0 + rl) * LDP + n0 + cl) = pack8(v0, v1); });
    } else if (n0 < LDP) {
      for_rows8b(acc, wr, wc, fr, fq, [&](int rl, int cl, int bj, f32x4 v0, f32x4 v1) {
        v0 += bv.v[bj][0]; v1 += bv.v[bj][1];
#pragma unroll
        for (int j = 0; j < 4; ++j) { v0[j] = sigmoidf_(v0[j]); v1[j] = sigmoidf_(v1[j]); }
        *(uint4*)(proj + (size_t)(m0 + rl) * LDP + n0 + cl) = pack8(v0, v1); });
    } else {
      for_rows8b(acc, wr, wc, fr, fq, [&](int rl, int cl, int bj, f32x4 v0, f32x4 v1) {
        if (cl < 16) {
          float* o = gates + (size_t)(m0 + rl) * 16 + cl;
          *(f32x4*)o = v0 + bv.v[bj][0]; *(f32x4*)(o + 4) = v1 + bv.v[bj][1];
        } });
    }
    return false;
  };
  gemm_phase8(c.lds, 1024, 1024, sched, epi, c.tid);
}

DI void phase_g2(const Ctx& c) {
  const char* xc = (const char*)(c.ws() + OFF_R2);
  const char* proj = (const char*)(c.ws() + OFF_R1);
  bf16_t* mq = (bf16_t*)(c.ws() + OFF_R3);
  bf16_t* mk = mq + (size_t)TG * 1024;
  bf16_t* mkt = mk + (size_t)TG * 1024;
  bf16_t* mvt = mkt + (size_t)TG * 1024;
  const char* wqkv = (const char*)c.W(W_QKV);
  constexpr int nM = TG / 256;
  {
    auto sched = [&](int i, GUnit& u) -> bool {
      const int L = i * c.nb + c.bid; if (L >= nM * 8) return false;
      u.pm = L >> 3; u.pn = L & 3; u.tag = (L >> 2) & 1;
      u.A = xc + ((size_t)u.pm * 256 * 1024 + u.pn * 256) * 2; u.B = wqkv + (size_t)(u.tag * 4 + u.pn) * 65536 * 2; u.nt = 4; return true; };
    auto epi = [&](GAcc& acc, const GUnit& u, int wr, int wc, int fr, int fq) -> bool {
      bf16_t* dst = (u.tag ? mk : mq) + (size_t)u.pm * 256 * 1024 + u.pn * 256;
      for_rows8(acc, wr, wc, fr, fq, [&](int rl, int cl, f32x4 v0, f32x4 v1) { *(uint4*)(dst + (size_t)rl * 1024 + cl) = pack8(v0, v1); }); return false; };
    int t1 = c.tid; asm volatile("" : "+v"(t1));
    gemm_phase8(c.lds, 1024, 256, sched, epi, t1);
  }
  {
    auto sched = [&](int i, GUnit& u) -> bool {
      const int L = i * c.nb + c.bid; if (L >= nM * 4) return false;
      u.pm = L >> 2; u.pn = L & 3; u.tag = 0;
      u.A = wqkv + (size_t)(4 + u.pn) * 65536 * 2; u.B = xc + ((size_t)u.pm * 256 * 1024 + u.pn * 256) * 2; u.nt = 4; return true; };
    auto epi = [&](GAcc& acc, const GUnit& u, int wr, int wc, int fr, int fq) -> bool {
      const int tok0 = u.pm * 256, seq = tok0 >> 11, s0 = tok0 & (SEQ - 1);
      bf16_t* dst = mkt + ((size_t)(seq * 4 + u.pn) * 256) * SEQ + s0;
      for_rows8(acc, wr, wc, fr, fq, [&](int rl, int cl, f32x4 v0, f32x4 v1) { *(uint4*)(dst + (size_t)rl * SEQ + cl) = pack8(v0, v1); }); return false; };
    int t2 = c.tid; asm volatile("" : "+v"(t2));
    gemm_phase8(c.lds, 256, 1024, sched, epi, t2);
  }
  {
    auto sched = [&](int i, GUnit& u) -> bool {
      const int L = i * c.nb + c.bid; if (L >= nM * 4) return false;
      u.pm = L >> 2; u.pn = L & 3; u.tag = 0;
      u.A = wqkv + (size_t)(8 + u.pn) * 65536 * 2; u.B = proj + ((size_t)u.pm * 256 * LDP + P_XM + u.pn * 256) * 2; u.nt = 4; return true; };
    auto epi = [&](GAcc& acc, const GUnit& u, int wr, int wc, int fr, int fq) -> bool {
      const int tok0 = u.pm * 256, seq = tok0 >> 11, s0 = tok0 & (SEQ - 1);
      bf16_t* dst = mvt + ((size_t)(seq * 4 + u.pn) * 256) * SEQ + s0;
      for_rows8(acc, wr, wc, fr, fq, [&](int rl, int cl, f32x4 v0, f32x4 v1) { *(uint4*)(dst + (size_t)rl * SEQ + cl) = pack8(v0, v1); }); return false; };
    int t3 = c.tid; asm volatile("" : "+v"(t3));
    gemm_phase8(c.lds, 256, LDP, sched, epi, t3);
  }
}

DI void phase_merge(const Ctx& c) {
  const char* ym = (const char*)(c.ws() + OFF_R2);
  const char* yac = (const char*)(c.ws() + OFF_R5);
  const bf16_t* proj = (const bf16_t*)(c.ws() + OFF_R1);
  bf16_t* merged = (bf16_t*)(c.ws() + OFF_R3);
  const char* wpm = (const char*)c.W(W_PM);
  const char* wpa = (const char*)c.W(W_PA);
  constexpr int nM = TG / 256, nN = 4;
  auto sched = [&](int i, GUnit& u) -> bool {
    const int j = i / 3, b = i - j * 3;
    const int L = j * c.nb + c.bid; if (L >= nM * nN) return false;
    static_unit(L, nM, nN, u.pm, u.pn);
    u.tag = b; u.nt = (b == 0) ? 16 : 8;
    u.A = ((b == 0) ? ym : yac + (b == 2 ? 1024 : 0)) + (size_t)u.pm * 256 * 1024 * 2;
    u.B = ((b == 0) ? wpm : wpa + (b == 2 ? 1024 : 0)) + (size_t)u.pn * 256 * 1024 * 2;
    return true; };
  auto epi = [&](GAcc& acc, const GUnit& u, int wr, int wc, int fr, int fq) -> bool {
    const int m0 = u.pm * 256, n0 = u.pn * 256, b = u.tag;
    const bf16_t* gp = proj + (size_t)(m0 + wr * 64 + fr) * LDP + P_G + b * 1024 + n0 + wc * 32 + 8 * fq;
#pragma unroll
    for (int ai = 0; ai < 2; ++ai) {
      uint4 g[4][2], gn[4][2];
#pragma unroll
      for (int m = 0; m < 4; ++m)
#pragma unroll
        for (int bj = 0; bj < 2; ++bj) {
          const bf16_t* q = gp + (size_t)(ai * 128 + m * 16) * LDP + bj * 128;
          g[m][bj] = *(const uint4*)q;
          if (b < 2) gn[m][bj] = *(const uint4*)(q + 1024);
        }
#pragma unroll
      for (int m = 0; m < 4; ++m)
#pragma unroll
        for (int bj = 0; bj < 2; ++bj) {
          const uint4 gg = g[m][bj];
          f32x4 g0 = {lo2f(gg.x), hi2f(gg.x), lo2f(gg.y), hi2f(gg.y)}, g1 = {lo2f(gg.z), hi2f(gg.z), lo2f(gg.w), hi2f(gg.w)};
          if (b < 2) {
            const uint4 hh = gn[m][bj];
            const f32x4 h0 = {lo2f(hh.x), hi2f(hh.x), lo2f(hh.y), hi2f(hh.y)}, h1 = {lo2f(hh.z), hi2f(hh.z), lo2f(hh.w), hi2f(hh.w)};
#pragma unroll
            for (int j = 0; j < 4; ++j) { g0[j] *= __builtin_amdgcn_rcpf(fmaxf(h0[j], 1e-30f)); g1[j] *= __builtin_amdgcn_rcpf(fmaxf(h1[j], 1e-30f)); }
            acc[ai][bj][m][0] *= g0; acc[ai][bj][m][1] *= g1;
          } else {
            const size_t row = m0 + ai * 128 + wr * 64 + m * 16 + fr; const int col = n0 + bj * 128 + wc * 32 + 8 * fq;
            *(uint4*)(merged + row * 1024 + col) = pack8(g0 * acc[ai][bj][m][0], g1 * acc[ai][bj][m][1]);
          }
        }
    }
    return b < 2;
  };
  gemm_phase8(c.lds, 1024, 1024, sched, epi, c.tid);
}

DI void phase_wout(const Ctx& c) {
  const char* merged = (const char*)(c.ws() + OFF_R3);
  bf16_t* pre = (bf16_t*)(c.ws() + OFF_R3 + 64 * MiB);
  const char* wt = (const char*)c.W(W_OUT);
  constexpr int nM = TG / 256, nN = 4;
  auto sched = [&](int i, GUnit& u) -> bool {
    const int L = i * c.nb + c.bid; if (L >= nM * nN) return false;
    static_unit(L, nM, nN, u.pm, u.pn);
    u.A = merged + (size_t)u.pm * 256 * 1024 * 2; u.B = wt + (size_t)u.pn * 256 * 1024 * 2; u.nt = 16; u.tag = 0; return true; };
  auto epi = [&](GAcc& acc, const GUnit& u, int wr, int wc, int fr, int fq) -> bool {
    const int m0 = u.pm * 256, n0 = u.pn * 256;
    const ColVec gv = load_cols(c.mod(2, m0 >> 11) + n0, wc, fq);
    for_rows8b(acc, wr, wc, fr, fq, [&](int rl, int cl, int bj, f32x4 v0, f32x4 v1) {
      const size_t off = (size_t)(m0 + rl) * 1024 + n0 + cl;
      *(uint4*)(pre + off) = pack8((gv.v[bj][0] + 1.f) * v0, (gv.v[bj][1] + 1.f) * v1); }); return false; };
  gemm_phase8(c.lds, 1024, 1024, sched, epi, c.tid);
}

DI void phase_mlp1(const Ctx& c) {
  const char* xm = (const char*)(c.ws() + OFF_R0);
  bf16_t* hid = (bf16_t*)(c.ws() + OFF_R1);
  const float* b1 = c.in(I_B1) + (size_t)c.l * 4096;
  const char* wt = (const char*)c.W(W_1);
  constexpr int nM = TG / 256, nN = 16;
  auto sched = [&](int i, GUnit& u) -> bool {
    const int L = i * c.nb + c.bid; if (L >= nM * nN) return false;
    static_unit(L, nM, nN, u.pm, u.pn);
    u.A = xm + (size_t)u.pm * 256 * 1024 * 2; u.B = wt + (size_t)u.pn * 256 * 1024 * 2; u.nt = 16; u.tag = 0; return true; };
  auto epi = [&](GAcc& acc, const GUnit& u, int wr, int wc, int fr, int fq) -> bool {
    const int m0 = u.pm * 256, n0 = u.pn * 256;
    const ColVec bv = load_cols(b1 + n0, wc, fq);
    for_rows8b(acc, wr, wc, fr, fq, [&](int rl, int cl, int bj, f32x4 v0, f32x4 v1) {
      v0 += bv.v[bj][0]; v1 += bv.v[bj][1];
#pragma unroll
      for (int j = 0; j < 4; ++j) { const float a = fmaxf(v0[j], 0.f), b = fmaxf(v1[j], 0.f); v0[j] = a * a; v1[j] = b * b; }
      *(uint4*)(hid + (size_t)(m0 + rl) * 4096 + n0 + cl) = pack8(v0, v1); }); return false; };
  gemm_phase8(c.lds, 1024, 1024, sched, epi, c.tid);
}

DI void phase_mlp2(const Ctx& c) {
  const char* hid = (const char*)(c.ws() + OFF_R1);
  bf16_t* pre = (bf16_t*)(c.ws() + OFF_R1 + 256 * MiB);
  const float* b2 = c.in(I_B2) + (size_t)c.l * 1024;
  const char* wt = (const char*)c.W(W_2);
  constexpr int nM = TG / 256, nN = 4;
  auto sched = [&](int i, GUnit& u) -> bool {
    const int L = i * c.nb + c.bid; if (L >= nM * nN) return false;
    static_unit(L, nM, nN, u.pm, u.pn);
    u.A = hid + (size_t)u.pm * 256 * 4096 * 2; u.B = wt + (size_t)u.pn * 256 * 4096 * 2; u.nt = 64; u.tag = 0; return true; };
  auto epi = [&](GAcc& acc, const GUnit& u, int wr, int wc, int fr, int fq) -> bool {
    const int m0 = u.pm * 256, n0 = u.pn * 256;
    const ColVec gv = load_cols(c.mod(5, m0 >> 11) + n0, wc, fq), bv = load_cols(b2 + n0, wc, fq);
    for_rows8b(acc, wr, wc, fr, fq, [&](int rl, int cl, int bj, f32x4 v0, f32x4 v1) {
      const size_t off = (size_t)(m0 + rl) * 1024 + n0 + cl;
      *(uint4*)(pre + off) = pack8((gv.v[bj][0] + 1.f) * (v0 + bv.v[bj][0]), (gv.v[bj][1] + 1.f) * (v1 + bv.v[bj][1])); }); return false; };
  gemm_phase8(c.lds, 4096, 4096, sched, epi, c.tid);
}

DI void gate_prepass(const Ctx& c) {
  const float* gates = (const float*)(c.ws() + OFF_GATES);
  float* ga = (float*)(c.ws() + OFF_GPRE);
  float* gb = ga + 128 * SEQ; float* gc = gb + 128 * SEQ; float* gt = gc + 128 * SEQ;
  const int lane = c.tid & 63;
  const int gw = c.bid * (NT / 64) + (c.tid >> 6), nw_ = c.nb * (NT / 64);
  for (int idx = gw; idx < GSEQ * 4 * 2 * 32; idx += nw_) {
    const int cj = idx & 31, dir = (idx >> 5) & 1, head = (idx >> 6) & 3, seq = idx >> 8;
    const int p = dir ? 63 - lane : lane;
    const int t = seq * SEQ + cj * 64 + p;
    const float ig = gates[(size_t)t * 16 + dir * 8 + head];
    const float fg = gates[(size_t)t * 16 + dir * 8 + 4 + head];
    float a = fminf(fg, 0.f) - log1pf(__expf(-fabsf(fg)));
#pragma unroll
    for (int o = 1; o < 64; o <<= 1) { const float tt = bperm(lane - o, a); if (lane >= o) a += tt; }
    const float b = ig - a;
    float cmb = b;
#pragma unroll
    for (int o = 1; o < 64; o <<= 1) { const float tt = bperm(lane - o, cmb); if (lane >= o) cmb = fmaxf(cmb, tt); }
    const size_t base = (size_t)((seq * 4 + head) * 2 + dir) * SEQ + cj * 64 + p;
    ga[base] = a; gb[base] = b; gc[base] = cmb;
    if (lane == 63) { float* g2 = gt + ((seq * 4 + head) * 2 + dir) * 64 + cj * 2; g2[0] = a; g2[1] = cmb; }
  }
}

#define MFMA16(a, b, c) __builtin_amdgcn_mfma_f32_16x16x32_bf16((a), (b), (c), 0, 0, 0)
DI bf16x8 frag_from(uint2 lo, uint2 hi) { uint4 u; u.x = lo.x; u.y = lo.y; u.z = hi.x; u.w = hi.y; return __builtin_bit_cast(bf16x8, u); }
DI bf16x8 frag_pack(f32x4 lo, f32x4 hi) { uint4 u; u.x = pack2(lo[0], lo[1]); u.y = pack2(lo[2], lo[3]); u.z = pack2(hi[0], hi[1]); u.w = pack2(hi[2], hi[3]); return __builtin_bit_cast(bf16x8, u); }

DI void scan_item(const Ctx& c, int item) {
  const int vh = item & 1, dir = (item >> 1) & 1, head = (item >> 2) & 3, seq = item >> 4;
  const int tid = c.tid, lane = tid & 63, wave = tid >> 6, n16 = lane & 15, q4 = lane >> 4;
  const bf16_t* mq = (const bf16_t*)(c.ws() + OFF_R3);
  const bf16_t* mk = mq + (size_t)TG * 1024;
  const bf16_t* mkt = mk + (size_t)TG * 1024;
  const bf16_t* mvt = mkt + (size_t)TG * 1024;
  const float* gpre = (const float*)(c.ws() + OFF_GPRE);
  bf16_t* hout = (bf16_t*)(c.ws() + (dir ? OFF_R2 : OFF_R0));
  bf16_t* Qs = c.lds;
  bf16_t* Ks = Qs + 16896;
  bf16_t* KTs = Ks + 16896;
  bf16_t* VT = KTs + 18432;
  bf16_t* VTs = VT + 9216;
  bf16_t* Ps = VTs + 9216;
  float* fl = (float*)(Ps + 4608);
  float* ns = fl;
  float* abc_s = fl + 256;
  float* a_s = abc_s; float* b_s = abc_s + 64; float* c_s = abc_s + 128;
  float* wg_s = abc_s + 192; float* den_s = wg_s + 64; float* gt_s = den_s + 64; float* winter_s = gt_s + 64; float* emrow_s = winter_s + 64;

  f32x4 cst[16];
#pragma unroll
  for (int kt = 0; kt < 16; ++kt) cst[kt] = (f32x4){0.f, 0.f, 0.f, 0.f};
  float nreg = 0.f, mstate = 0.f;
  if (tid < 256) ns[tid] = 0.f;
  const int gidx = (seq * 4 + head) * 2 + dir;
  if (tid < 64) gt_s[tid] = gpre[(size_t)3 * 128 * SEQ + gidx * 64 + tid];
  const size_t tbase = (size_t)(seq * 4 + head) * 256;
  const int lrow = tid >> 5, lkc = (tid & 31) * 8;
  const bf16_t* qsrc = mq + (size_t)(seq * SEQ + lrow) * 1024 + head * 256 + lkc;
  const bf16_t* ksrc = mk + (size_t)(seq * SEQ + lrow) * 1024 + head * 256 + lkc;
  const bf16_t* vsrc = mvt + (tbase + vh * 128 + (tid >> 3)) * SEQ + (tid & 7) * 8;
  const bf16_t* ktsrc = mkt + (tbase + (tid >> 3)) * SEQ + (tid & 7) * 8;
  const float* gsrc = gpre + (size_t)(tid >> 6) * 128 * SEQ + (size_t)gidx * SEQ + (tid & 63);
  uint4 rq0, rq1, rq2, rq3, rk0, rk1, rk2, rk3, rt0, rt1, rt2, rt3, rv0, rv1; float rg = 0.f;
#define PF_QK(cn) do { const size_t o_ = (size_t)(cn) * 64 * 1024; \
    rq0 = *(const uint4*)(qsrc + o_); rq1 = *(const uint4*)(qsrc + o_ + 16 * 1024); rq2 = *(const uint4*)(qsrc + o_ + 32 * 1024); rq3 = *(const uint4*)(qsrc + o_ + 48 * 1024); \
    rk0 = *(const uint4*)(ksrc + o_); rk1 = *(const uint4*)(ksrc + o_ + 16 * 1024); rk2 = *(const uint4*)(ksrc + o_ + 32 * 1024); rk3 = *(const uint4*)(ksrc + o_ + 48 * 1024); } while (0)
#define PF_TV(cn) do { \
    rt0 = *(const uint4*)(ktsrc + (cn) * 64); rt1 = *(const uint4*)(ktsrc + (size_t)64 * SEQ + (cn) * 64); \
    rt2 = *(const uint4*)(ktsrc + (size_t)128 * SEQ + (cn) * 64); rt3 = *(const uint4*)(ktsrc + (size_t)192 * SEQ + (cn) * 64); \
    rv0 = *(const uint4*)(vsrc + (cn) * 64); rv1 = *(const uint4*)(vsrc + (size_t)64 * SEQ + (cn) * 64); \
    if (tid < 192) rg = gsrc[(cn) * 64]; } while (0)
#define PUT_QK() do { bf16_t* qd = Qs + lrow * 264 + lkc; bf16_t* kd = Ks + lrow * 264 + lkc; \
    *(uint4*)(qd) = rq0; *(uint4*)(qd + 16 * 264) = rq1; *(uint4*)(qd + 32 * 264) = rq2; *(uint4*)(qd + 48 * 264) = rq3; \
    *(uint4*)(kd) = rk0; *(uint4*)(kd + 16 * 264) = rk1; *(uint4*)(kd + 32 * 264) = rk2; *(uint4*)(kd + 48 * 264) = rk3; } while (0)
  PF_QK(dir ? 31 : 0); PF_TV(dir ? 31 : 0);
  PUT_QK();
  __syncthreads();

#pragma unroll 1
  for (int j = 0; j < 32; ++j) {
    const int cj = dir ? 31 - j : j;
    const int t0 = seq * SEQ + cj * 64;
    const float Atot = gt_s[cj * 2], cmbl = gt_s[cj * 2 + 1];
    const float m_new = Atot + fmaxf(mstate, cmbl);
    const float decay = __expf(Atot + mstate - m_new);
    {
      bf16_t* kw = KTs + (tid >> 3) * 72 + (tid & 7) * 8;
      *(uint4*)(kw) = rt0; *(uint4*)(kw + 64 * 72) = rt1; *(uint4*)(kw + 128 * 72) = rt2; *(uint4*)(kw + 192 * 72) = rt3;
      bf16_t* vw = VT + (tid >> 3) * 72 + (tid & 7) * 8;
      *(uint4*)(vw) = rv0; *(uint4*)(vw + 64 * 72) = rv1;
      if (tid < 192) abc_s[tid] = rg;
      if (tid >= 128 && tid < 192) winter_s[tid - 128] = __expf(mstate - fmaxf(mstate, rg));
    }
    __syncthreads();
    {
      const int sc = (tid & 7) * 8;
      const float4 q0 = *(const float4*)(b_s + sc), q1 = *(const float4*)(b_s + sc + 4);
      const float e0 = Atot - m_new;
      const float w0 = __expf(e0 + q0.x), w1 = __expf(e0 + q0.y), w2 = __expf(e0 + q0.z), w3 = __expf(e0 + q0.w);
      const float w4_ = __expf(e0 + q1.x), w5 = __expf(e0 + q1.y), w6 = __expf(e0 + q1.z), w7 = __expf(e0 + q1.w);
#pragma unroll
      for (int i = 0; i < 2; ++i) {
        const int v = (tid >> 3) + 64 * i;
        const uint4 raw = *(const uint4*)(VT + v * 72 + sc);
        uint4 o;
        o.x = pack2(lo2f(raw.x) * w0, hi2f(raw.x) * w1); o.y = pack2(lo2f(raw.y) * w2, hi2f(raw.y) * w3);
        o.z = pack2(lo2f(raw.z) * w4_, hi2f(raw.z) * w5); o.w = pack2(lo2f(raw.w) * w6, hi2f(raw.w) * w7);
        *(uint4*)(VTs + v * 72 + sc) = o;
      }
      if (tid < 64) { wg_s[tid] = __expf(e0 + b_s[tid]); emrow_s[tid] = __expf(-(a_s[tid] + fmaxf(mstate, c_s[tid]))); }
    }
    {
      const int lt = wave >> 1, st0 = (wave & 1) * 2;
      f32x4 sacc0 = {0.f, 0.f, 0.f, 0.f}, sacc1 = {0.f, 0.f, 0.f, 0.f};
      const bf16_t* ap = Qs + (16 * lt + n16) * 264 + 8 * q4;
      const bf16_t* bp = Ks + (16 * st0 + n16) * 264 + 8 * q4;
#pragma unroll
      for (int kk = 0; kk < 8; ++kk) {
        const bf16x8 a = *(const bf16x8*)(ap + 32 * kk);
        sacc0 = MFMA16(a, *(const bf16x8*)(bp + 32 * kk), sacc0);
        sacc1 = MFMA16(a, *(const bf16x8*)(bp + 16 * 264 + 32 * kk), sacc1);
      }
#pragma unroll
      for (int i = 0; i < 2; ++i) {
        const int scol = 16 * (st0 + i) + n16;
        const float bcol = b_s[scol];
#pragma unroll
        for (int jj = 0; jj < 4; ++jj) {
          const int lr = 16 * lt + 4 * q4 + jj;
          const bool valid = dir ? (scol >= lr) : (scol <= lr);
          const float sv = i ? sacc1[jj] : sacc0[jj];
          const float pv = valid ? sv * __expf(bcol - fmaxf(mstate, c_s[lr])) : 0.f;
          Ps[lr * 72 + scol] = f2bf(pv);
        }
      }
    }
    f32x4 iacc[4];
#pragma unroll
    for (int lt = 0; lt < 4; ++lt) iacc[lt] = (f32x4){0.f, 0.f, 0.f, 0.f};
#pragma unroll
    for (int kb = 0; kb < 8; ++kb) {
      const bf16x8 bfrag = frag_pack(cst[2 * kb], cst[2 * kb + 1]);
#pragma unroll
      for (int lt = 0; lt < 4; ++lt) {
        const bf16_t* qp = Qs + (16 * lt + n16) * 264 + 32 * kb + 4 * q4;
        iacc[lt] = MFMA16(frag_from(*(const uint2*)qp, *(const uint2*)(qp + 16)), bfrag, iacc[lt]);
      }
      __builtin_amdgcn_sched_barrier(0);
    }
#pragma unroll
    for (int lt = 0; lt < 4; ++lt) iacc[lt] *= *(const f32x4*)(winter_s + 16 * lt + 4 * q4);
    __syncthreads();
    if (j + 1 < 32) { PF_QK(dir ? cj - 1 : cj + 1); PF_TV(dir ? cj - 1 : cj + 1); }
#pragma unroll
    for (int ss = 0; ss < 2; ++ss) {
      const bf16x8 b = *(const bf16x8*)(VT + (16 * wave + n16) * 72 + 32 * ss + 8 * q4);
#pragma unroll
      for (int lt = 0; lt < 4; ++lt) iacc[lt] = MFMA16(*(const bf16x8*)(Ps + (16 * lt + n16) * 72 + 32 * ss + 8 * q4), b, iacc[lt]);
    }
    {
      const int l = tid >> 3, part = tid & 7;
      float qn = 0.f;
#pragma unroll
      for (int i = 0; i < 4; ++i) {
        const uint4 q = *(const uint4*)(Qs + l * 264 + part * 32 + i * 8);
        const float4 n0 = *(const float4*)(ns + part * 32 + i * 8), n1 = *(const float4*)(ns + part * 32 + i * 8 + 4);
        qn += lo2f(q.x) * n0.x + hi2f(q.x) * n0.y + lo2f(q.y) * n0.z + hi2f(q.y) * n0.w + lo2f(q.z) * n1.x + hi2f(q.z) * n1.y + lo2f(q.w) * n1.z +
              hi2f(q.w) * n1.w;
      }
      const uint4 pq = *(const uint4*)(Ps + l * 72 + part * 8);
      const float ps = lo2f(pq.x) + hi2f(pq.x) + lo2f(pq.y) + hi2f(pq.y) + lo2f(pq.z) + hi2f(pq.z) + lo2f(pq.w) + hi2f(pq.w);
      float tot = ps + winter_s[l] * qn;
      tot += sx<1>(tot); tot += sx<2>(tot); tot += sx<4>(tot);
      if (part == 0) den_s[l] = tot;
    }
    __syncthreads();
#pragma unroll
    for (int lt = 0; lt < 4; ++lt)
#pragma unroll
      for (int jj = 0; jj < 4; ++jj) {
        const int lr = 16 * lt + 4 * q4 + jj;
        const float d = fmaxf(fabsf(den_s[lr]), emrow_s[lr]);
        hout[(size_t)(t0 + lr) * 1024 + head * 256 + vh * 128 + 16 * wave + n16] = f2bf(iacc[lt][jj] * __builtin_amdgcn_rcpf(d));
      }
    if (tid < 256) {
      float s = 0.f;
#pragma unroll
      for (int i = 0; i < 8; ++i) {
        const uint4 q = *(const uint4*)(KTs + tid * 72 + i * 8);
        const float4 g0 = *(const float4*)(wg_s + i * 8), g1 = *(const float4*)(wg_s + i * 8 + 4);
        s += lo2f(q.x) * g0.x + hi2f(q.x) * g0.y + lo2f(q.y) * g0.z + hi2f(q.y) * g0.w + lo2f(q.z) * g1.x + hi2f(q.z) * g1.y + lo2f(q.w) * g1.z +
             hi2f(q.w) * g1.w;
      }
      nreg = decay * nreg + s;
      ns[tid] = nreg;
    }
    {
      const bf16_t* bp = VTs + (16 * wave + n16) * 72 + 8 * q4;
      const bf16x8 b0 = *(const bf16x8*)(bp), b1 = *(const bf16x8*)(bp + 32);
      const bf16_t* ap = KTs + n16 * 72 + 8 * q4;
#pragma unroll
      for (int kt = 0; kt < 16; ++kt) {
        cst[kt] *= decay;
        cst[kt] = MFMA16(*(const bf16x8*)(ap + kt * 16 * 72), b0, cst[kt]);
        cst[kt] = MFMA16(*(const bf16x8*)(ap + kt * 16 * 72 + 32), b1, cst[kt]);
        if ((kt & 3) == 3) __builtin_amdgcn_sched_barrier(0);
      }
    }
    if (j + 1 < 32) PUT_QK();
    mstate = m_new;
    __syncthreads();
  }
#undef PF_QK
#undef PF_TV
#undef PUT_QK
}

DI void attn_item(const Ctx& c, int item) {
  const int kvg = item & 1, hh = (item >> 1) & 1, qb = (item >> 2) & 15, seq = item >> 6;
  const int tid = c.tid, lane = tid & 63, wave = tid >> 6, r = lane & 31, h = lane >> 5;
  const bf16_t* proj = (const bf16_t*)(c.ws() + OFF_R1);
  bf16_t* ya = (bf16_t*)(c.ws() + OFF_R5);
  bf16_t* Kt = c.lds;
  bf16_t* VTt = Kt + 9216;
  const int head = kvg * 4 + hh * 2 + (wave >> 2), slice = wave & 3;
  const float L2E = 1.4426950408889634f;
  const float nslope2 = -exp2f(-(float)(head + 1)) * L2E, qscale2 = 0.125f * L2E;
  const float sink = c.in(I_SINK)[c.l * 8 + head] * L2E;
  const int q0 = qb * 128 + slice * 32;
  bf16x8 qf[4];
#pragma unroll
  for (int ks = 0; ks < 4; ++ks)
    qf[ks] = *(const bf16x8*)(proj + (size_t)(seq * SEQ + q0 + r) * LDP + P_AQ + head * 64 + ks * 16 + h * 8);
  f32x16 O[2];
#pragma unroll
  for (int e = 0; e < 16; ++e) { O[0][e] = 0.f; O[1][e] = 0.f; }
  float mrun = sink, lsum = 0.f;
  const int kb_lo = (qb == 0) ? 1 : 0, kb_hi = (qb == 15) ? 2 : 3;
  const int kkey = tid >> 3, kdc = (tid & 7) * 8, vkey = tid & 127, vdc = (tid >> 7) * 16;
  const bf16_t* kbase = proj + (size_t)(seq * SEQ + qb * 128 - 128) * LDP + P_AK + kvg * 64;
  const bf16_t* vbase = proj + (size_t)(seq * SEQ + qb * 128 - 128) * LDP + P_AV + kvg * 64;
  uint4 rk0, rk1, rv0, rv1;
  {
    const size_t o = (size_t)kb_lo * 128 * LDP;
    rk0 = *(const uint4*)(kbase + o + (size_t)kkey * LDP + kdc); rk1 = *(const uint4*)(kbase + o + (size_t)(kkey + 64) * LDP + kdc);
    rv0 = *(const uint4*)(vbase + o + (size_t)vkey * LDP + vdc); rv1 = *(const uint4*)(vbase + o + (size_t)vkey * LDP + vdc + 8);
  }
#pragma unroll 1
  for (int kb = kb_lo; kb < kb_hi; ++kb) {
    const int kstart = qb * 128 - 128 + kb * 128;
    *(uint4*)(Kt + kkey * 72 + kdc) = rk0; *(uint4*)(Kt + (kkey + 64) * 72 + kdc) = rk1;
    {
      bf16_t* vd = VTt + vdc * 136 + vkey;
      vd[0 * 136] = (bf16_t)(rv0.x & 0xffff); vd[1 * 136] = (bf16_t)(rv0.x >> 16); vd[2 * 136] = (bf16_t)(rv0.y & 0xffff); vd[3 * 136] = (bf16_t)(rv0.y >> 16);
      vd[4 * 136] = (bf16_t)(rv0.z & 0xffff); vd[5 * 136] = (bf16_t)(rv0.z >> 16); vd[6 * 136] = (bf16_t)(rv0.w & 0xffff); vd[7 * 136] = (bf16_t)(rv0.w >> 16);
      vd[8 * 136] = (bf16_t)(rv1.x & 0xffff); vd[9 * 136] = (bf16_t)(rv1.x >> 16); vd[10 * 136] = (bf16_t)(rv1.y & 0xffff); vd[11 * 136] = (bf16_t)(rv1.y >> 16);
      vd[12 * 136] = (bf16_t)(rv1.z & 0xffff); vd[13 * 136] = (bf16_t)(rv1.z >> 16); vd[14 * 136] = (bf16_t)(rv1.w & 0xffff); vd[15 * 136] = (bf16_t)(rv1.w >> 16);
    }
    __syncthreads();
    if (kb + 1 < kb_hi) {
      const size_t o = (size_t)(kb + 1) * 128 * LDP;
      rk0 = *(const uint4*)(kbase + o + (size_t)kkey * LDP + kdc); rk1 = *(const uint4*)(kbase + o + (size_t)(kkey + 64) * LDP + kdc);
      rv0 = *(const uint4*)(vbase + o + (size_t)vkey * LDP + vdc); rv1 = *(const uint4*)(vbase + o + (size_t)vkey * LDP + vdc + 8);
    }
    f32x16 s[4];
#pragma unroll
    for (int nt = 0; nt < 4; ++nt) {
#pragma unroll
      for (int e = 0; e < 16; ++e) s[nt][e] = 0.f;
#pragma unroll
      for (int ks = 0; ks < 4; ++ks) s[nt] = MFMA(*(const bf16x8*)(Kt + (nt * 32 + r) * 72 + ks * 16 + h * 8), qf[ks], s[nt]);
    }
    const float drel = (float)(kstart - (q0 + r) + 4 * h);
    float mx = -INFINITY;
    if (kstart == qb * 128) {
#pragma unroll
      for (int nt = 0; nt < 4; ++nt)
#pragma unroll
        for (int e = 0; e < 16; ++e) {
          const float d = drel + (float)(nt * 32 + (e & 3) + 8 * (e >> 2));
          const float v = fmaf(nslope2, fabsf(d), s[nt][e] * qscale2);
          s[nt][e] = v; mx = fmaxf(mx, v);
        }
    } else {
#pragma unroll
      for (int nt = 0; nt < 4; ++nt)
#pragma unroll
        for (int e = 0; e < 16; ++e) {
          const float d = drel + (float)(nt * 32 + (e & 3) + 8 * (e >> 2));
          const float v = (fabsf(d) <= 128.f) ? fmaf(nslope2, fabsf(d), s[nt][e] * qscale2) : -INFINITY;
          s[nt][e] = v; mx = fmaxf(mx, v);
        }
    }
    mx = fmaxf(mx, bperm(lane ^ 32, mx));
    const float mn = fmaxf(mrun, mx);
    const float alpha = __builtin_amdgcn_exp2f(mrun - mn);
    mrun = mn;
    float ls = 0.f;
#pragma unroll
    for (int nt = 0; nt < 4; ++nt)
#pragma unroll
      for (int e = 0; e < 16; ++e) { const float pv = __builtin_amdgcn_exp2f(s[nt][e] - mn); s[nt][e] = pv; ls += pv; }
    lsum = lsum * alpha + ls;
#pragma unroll
    for (int e = 0; e < 16; ++e) { O[0][e] *= alpha; O[1][e] *= alpha; }
#pragma unroll
    for (int nt = 0; nt < 4; ++nt)
#pragma unroll
      for (int s2 = 0; s2 < 2; ++s2) {
        uint4 pu;
        pu.x = pack2(s[nt][8 * s2], s[nt][8 * s2 + 1]); pu.y = pack2(s[nt][8 * s2 + 2], s[nt][8 * s2 + 3]);
        pu.z = pack2(s[nt][8 * s2 + 4], s[nt][8 * s2 + 5]); pu.w = pack2(s[nt][8 * s2 + 6], s[nt][8 * s2 + 7]);
        const bf16x8 pfrag = __builtin_bit_cast(bf16x8, pu);
        const bf16_t* vp = VTt + r * 136 + nt * 32 + 16 * s2 + 4 * h;
        O[0] = MFMA(frag_from(*(const uint2*)vp, *(const uint2*)(vp + 8)), pfrag, O[0]);
        O[1] = MFMA(frag_from(*(const uint2*)(vp + 32 * 136), *(const uint2*)(vp + 32 * 136 + 8)), pfrag, O[1]);
      }
    __syncthreads();
  }
  float l = lsum + bperm(lane ^ 32, lsum);
  l += __builtin_amdgcn_exp2f(sink - mrun);
  const float inv = 1.f / l;
  bf16_t* op = ya + (size_t)(seq * SEQ + q0 + r) * 1024 + head * 64 + 4 * h;
#pragma unroll
  for (int dt = 0; dt < 2; ++dt)
#pragma unroll
    for (int g = 0; g < 4; ++g) {
      uint2 o; o.x = pack2(O[dt][4 * g] * inv, O[dt][4 * g + 1] * inv); o.y = pack2(O[dt][4 * g + 2] * inv, O[dt][4 * g + 3] * inv);
      *(uint2*)(op + dt * 32 + 8 * g) = o;
    }
}

DI void sgu_item(const Ctx& c, int item) {
  const int chunk = item & 15, seq = item >> 4;
  const int tid = c.tid, lane = tid & 63, wave = tid >> 6, r = lane & 31, h = lane >> 5;
  const bf16_t* proj = (const bf16_t*)(c.ws() + OFF_R1);
  bf16_t* yc = (bf16_t*)(c.ws() + OFF_R5) + 512;
  bf16_t* wsb = c.lds;
  bf16_t* vnT = wsb + 128 * 136;
  float* mean_s = (float*)(vnT + 128 * 136); float* rstd_s = mean_s + 128;
  const int t0 = seq * SEQ + chunk * 128;
  const float* lnw = c.in(I_CLNW) + (size_t)c.l * 512;
  const float* lnb = c.in(I_CLNB) + (size_t)c.l * 512;
  {
    const int tok = tid >> 2, part = tid & 3;
    float s = 0.f, q = 0.f;
#pragma unroll
    for (int i = 0; i < 16; ++i) {
      const uint4 v = *(const uint4*)(proj + (size_t)(t0 + tok) * LDP + P_V + part * 128 + i * 8);
      const float f[8] = {lo2f(v.x), hi2f(v.x), lo2f(v.y), hi2f(v.y), lo2f(v.z), hi2f(v.z), lo2f(v.w), hi2f(v.w)};
#pragma unroll
      for (int jj = 0; jj < 8; ++jj) { s += f[jj]; q += f[jj] * f[jj]; }
    }
    s += sx<1>(s); s += sx<2>(s); q += sx<1>(q); q += sx<2>(q);
    const float mean = s * (1.f / 512.f);
    const float var = fmaxf(q * (1.f / 512.f) - mean * mean, 0.f);
    if (part == 0) { mean_s[tok] = mean; rstd_s[tok] = rsqrtf(var + LN_EPS); }
  }
  __syncthreads();
  const int ct = wave >> 1, tt0 = (wave & 1) * 2;
  const int ws_t = tid >> 5, ws_q = (tid & 31) * 4;
  const int vs_s = tid & 127, vs_c = (tid >> 7) * 8;
  float4 rw[8]; uint4 rv[4];
#define SGU_PREFETCH(g_) do { const float* wsg_ = c.in(I_CWS) + ((size_t)(c.l * 4 + (g_))) * 16384; \
    _Pragma("unroll") for (int i = 0; i < 8; ++i) rw[i] = *(const float4*)(wsg_ + (ws_t + 16 * i) * 128 + ws_q); \
    _Pragma("unroll") for (int i = 0; i < 4; ++i) rv[i] = *(const uint4*)(proj + (size_t)(t0 + vs_s) * LDP + P_V + (g_) * 128 + vs_c + 32 * i); } while (0)
  SGU_PREFETCH(0);
#pragma unroll 1
  for (int gq = 0; gq < 4; ++gq) {
#pragma unroll
    for (int i = 0; i < 8; ++i) { uint2 o; o.x = pack2(rw[i].x, rw[i].y); o.y = pack2(rw[i].z, rw[i].w); *(uint2*)(wsb + (ws_t + 16 * i) * 136 + ws_q) = o; }
    {
      const float mean = mean_s[vs_s], rstd = rstd_s[vs_s];
#pragma unroll
      for (int i = 0; i < 4; ++i) {
        const int cc = vs_c + 32 * i;
        const uint4 v = rv[i];
        const float4 w0 = *(const float4*)(lnw + gq * 128 + cc), w1 = *(const float4*)(lnw + gq * 128 + cc + 4);
        const float4 b0 = *(const float4*)(lnb + gq * 128 + cc), b1 = *(const float4*)(lnb + gq * 128 + cc + 4);
        bf16_t* d = vnT + cc * 136 + vs_s;
        d[0 * 136] = f2bf((lo2f(v.x) - mean) * rstd * w0.x + b0.x); d[1 * 136] = f2bf((hi2f(v.x) - mean) * rstd * w0.y + b0.y);
        d[2 * 136] = f2bf((lo2f(v.y) - mean) * rstd * w0.z + b0.z); d[3 * 136] = f2bf((hi2f(v.y) - mean) * rstd * w0.w + b0.w);
        d[4 * 136] = f2bf((lo2f(v.z) - mean) * rstd * w1.x + b1.x); d[5 * 136] = f2bf((hi2f(v.z) - mean) * rstd * w1.y + b1.y);
        d[6 * 136] = f2bf((lo2f(v.w) - mean) * rstd * w1.z + b1.z); d[7 * 136] = f2bf((hi2f(v.w) - mean) * rstd * w1.w + b1.w);
      }
    }
    __syncthreads();
    if (gq < 3) SGU_PREFETCH(gq + 1);
    uint2 u[2][4];
    const float* bs = c.in(I_CBS) + ((size_t)(c.l * 4 + gq)) * 128;
    float bb[2];
#pragma unroll
    for (int i = 0; i < 2; ++i) {
      const int t = (tt0 + i) * 32 + r;
      bb[i] = bs[t];
      const bf16_t* up = proj + (size_t)(t0 + t) * LDP + P_U + gq * 128 + ct * 32 + 4 * h;
#pragma unroll
      for (int g = 0; g < 4; ++g) u[i][g] = *(const uint2*)(up + 8 * g);
    }
    f32x16 acc[2];
#pragma unroll
    for (int e = 0; e < 16; ++e) { acc[0][e] = 0.f; acc[1][e] = 0.f; }
#pragma unroll
    for (int ks = 0; ks < 8; ++ks) {
      const bf16x8 a = *(const bf16x8*)(vnT + (ct * 32 + r) * 136 + ks * 16 + h * 8);
      acc[0] = MFMA(a, *(const bf16x8*)(wsb + (tt0 * 32 + r) * 136 + ks * 16 + h * 8), acc[0]);
      acc[1] = MFMA(a, *(const bf16x8*)(wsb + (tt0 * 32 + 32 + r) * 136 + ks * 16 + h * 8), acc[1]);
    }
#pragma unroll
    for (int i = 0; i < 2; ++i) {
      const int t = (tt0 + i) * 32 + r;
      bf16_t* op = yc + (size_t)(t0 + t) * 1024 + gq * 128 + ct * 32 + 4 * h;
#pragma unroll
      for (int g = 0; g < 4; ++g) {
        uint2 o;
        o.x = pack2(lo2f(u[i][g].x) * (acc[i][4 * g] + bb[i]), hi2f(u[i][g].x) * (acc[i][4 * g + 1] + bb[i]));
        o.y = pack2(lo2f(u[i][g].y) * (acc[i][4 * g + 2] + bb[i]), hi2f(u[i][g].y) * (acc[i][4 * g + 3] + bb[i]));
        *(uint2*)(op + 8 * g) = o;
      }
    }
    __syncthreads();
  }
#undef SGU_PREFETCH
}

DI void phase_mix(const Ctx& c) {
  constexpr int N_SCAN = GSEQ * 16, N_ATT = GSEQ * 64, N_SGU = GSEQ * 16;
  for (int it = c.bid; it < N_SCAN + N_ATT + N_SGU; it += c.nb) {
    Ctx c2 = c;
    asm volatile("" : "+v"(c2.tid));
    asm volatile("" : "+s"(c2.wsp));
    if (it < N_SCAN) { scan_item(c2, it);
#if REPEAT_SCAN
      __syncthreads(); asm volatile("" : "+v"(c2.tid)); scan_item(c2, it);
#endif
    }
    else if (it < N_SCAN + N_ATT) { attn_item(c2, it - N_SCAN);
#if REPEAT_ATT
      __syncthreads(); asm volatile("" : "+v"(c2.tid)); attn_item(c2, it - N_SCAN);
#endif
    }
    else sgu_item(c2, it - N_SCAN - N_ATT);
    __syncthreads();
  }
}

#define XB_TMO      128
#define XB_XCNT(j)  (256  + 64 * (j))
#define XB_XSUB(j)  (1280 + 64 * (j))
#define XB_XGEN(j)  (2304 + 64 * (j))
#define XB_TOP      3328
#define XB_TOPGEN   3392
#define XCD_BAR_WORDS 3456
#define XB_SPIN_CAP (1u << 18)
DI unsigned xb_ld(unsigned* p) { return __hip_atomic_load(p, __ATOMIC_RELAXED, __HIP_MEMORY_SCOPE_AGENT); }
DI unsigned xb_add(unsigned* p, unsigned v) { return __hip_atomic_fetch_add(p, v, __ATOMIC_RELAXED, __HIP_MEMORY_SCOPE_AGENT); }
DI unsigned xb_xcc_id() { return (unsigned)__builtin_amdgcn_s_getreg((3 << 11) | 20) & 0xFu; }
#define XB_SPIN(cond, bar) do { unsigned _sp = 0; while (cond) { __builtin_amdgcn_s_sleep(1); \
    if ((++_sp & 255u) == 0u) { if (xb_ld(&(bar)[XB_TMO])) break; if (_sp > XB_SPIN_CAP) { atomicAdd(&(bar)[XB_TMO], 1u); break; } } } } while (0)
struct XcdBarrier { unsigned* bar; unsigned x; volatile LAS unsigned* st; };
DI XcdBarrier xcd_barrier_post(unsigned* bar, volatile LAS unsigned* st) {
  XcdBarrier b; b.bar = bar; b.x = xb_xcc_id(); b.st = st;
  if (threadIdx.x == 0) (void)xb_add(&bar[XB_XCNT(b.x)], 1u);
  return b;
}
DI void xcd_barrier_complete(unsigned* bar, unsigned x, unsigned& nloc, unsigned& nx) {
  const unsigned G = gridDim.x * gridDim.y * gridDim.z;
  unsigned sum, cnt, mine, sp = 0u;
  for (;;) {
    sum = 0u; cnt = 0u; mine = 0u;
#pragma unroll
    for (unsigned j = 0; j < 16; ++j) { const unsigned c = xb_ld(&bar[XB_XCNT(j)]); sum += c; cnt += (c > 0u) ? 1u : 0u; mine = (j == x) ? c : mine; }
    if (sum == G) break;
    __builtin_amdgcn_s_sleep(1);
    if ((++sp & 255u) == 0u) { if (xb_ld(&bar[XB_TMO])) break; if (sp > XB_SPIN_CAP) { atomicAdd(&bar[XB_TMO], 1u); break; } }
  }
  nloc = mine > 0u ? mine : 1u; nx = cnt > 0u ? cnt : 1u;
}
DI void xcd_barrier(const XcdBarrier& b) {
  asm volatile("s_waitcnt vmcnt(0)" ::: "memory");
  __syncthreads();
  if (threadIdx.x == 0) {
    unsigned* bar = b.bar;
    __builtin_amdgcn_s_waitcnt(0);
    unsigned nloc = b.st[0], nx = b.st[1];
    if (nloc == 0u) { xcd_barrier_complete(bar, b.x, nloc, nx); b.st[0] = nloc; b.st[1] = nx; }
    const unsigned old = xb_add(&bar[XB_XSUB(b.x)], 1u);
    const unsigned gen = old / nloc;
    if (old + 1u == (gen + 1u) * nloc) {
      __builtin_amdgcn_fence(__ATOMIC_RELEASE, "agent");
      asm volatile("s_waitcnt vmcnt(0)" ::: "memory");
      const unsigned og = xb_add(&bar[XB_TOP], 1u);
      const unsigned tg = og / nx;
      if (og + 1u == (tg + 1u) * nx) xb_add(&bar[XB_TOPGEN], 1u);
      else XB_SPIN(xb_ld(&bar[XB_TOPGEN]) == tg, bar);
      __builtin_amdgcn_fence(__ATOMIC_ACQUIRE, "agent");
      xb_add(&bar[XB_XGEN(b.x)], 1u);
      asm volatile("s_waitcnt vmcnt(0)" ::: "memory");
    } else {
      XB_SPIN(xb_ld(&bar[XB_XGEN(b.x)]) == gen, bar);
      __builtin_amdgcn_fence(__ATOMIC_ACQUIRE, "agent");
      asm volatile("s_waitcnt vmcnt(0)" ::: "memory");
    }
  }
  __syncthreads();
}

constexpr int STEPS_PER_LAYER = 11, STEPS_PER_GROUP = 1 + DEPTH * STEPS_PER_LAYER, N_STEPS = 1 + NGROUP * STEPS_PER_GROUP;

DI void run_step(const Params& P, int step, bf16_t* lds) {
  int tid = threadIdx.x, bid = blockIdx.x, nb = gridDim.x;
  unsigned char* wsp = P.ws;
  asm volatile("" : "+v"(tid));
  asm volatile("" : "+s"(bid), "+s"(nb), "+s"(wsp));
  if (step == 0) {
    for (int it = bid; it < PREP_ITEMS; it += nb) prep_item(P, it, lds, tid);
    return;
  }
  step -= 1;
  Ctx c; c.p = &P; c.lds = lds; c.tid = tid; c.bid = bid; c.nb = nb; c.wsp = wsp;
  c.g = step / STEPS_PER_GROUP; int s = step - c.g * STEPS_PER_GROUP;
  if (s == 0) { c.l = 0; phase_xm0(c); return; }
  s -= 1; c.l = s / STEPS_PER_LAYER; s -= c.l * STEPS_PER_LAYER;
  const int l = c.l;
  switch (s) {
    case 0: phase_g1(c); break;
    case 1: phase_conv(c); gate_prepass(c); break;
    case 2: phase_g2(c); break;
    case 3: phase_mix(c); break;
    case 4: phase_post(c); break;
    case 5: phase_merge(c); break;
    case 6: phase_wout(c); break;
    case 7: phase_ln(c, (const bf16_t*)(wsp + OFF_R3 + 64 * MiB), c.xin(), c.in(I_LN1W) + l * 1024, c.in(I_LN1B) + l * 1024, l, 3, 4); break;
    case 8: phase_mlp1(c); break;
    case 9: phase_mlp2(c); break;
    case 10: phase_ln(c, (const bf16_t*)(wsp + OFF_R1 + 256 * MiB), c.xout(), c.in(I_LN2W) + l * 1024, c.in(I_LN2B) + l * 1024, (l + 1 < DEPTH) ? l + 1 : -1, 0, 1); break;
  }
}

__global__ void __launch_bounds__(NT) fwd_megakernel(Params P) {
  extern __shared__ __attribute__((aligned(16))) unsigned char smem[];
  bf16_t* lds = (bf16_t*)smem;
  cg::grid_group grid = cg::this_grid();
  volatile LAS unsigned* xst = (volatile LAS unsigned*)(LAS unsigned char*)(smem + LDS_WORK);
  if (threadIdx.x < 4) xst[threadIdx.x] = 0u;
  __syncthreads();
  const XcdBarrier xb = xcd_barrier_post((unsigned*)(P.ws + OFF_BAR), xst);
  for (int s = P.step_lo; s < P.step_hi; ++s) {
    run_step(P, s, lds);
#if REPEAT_MASK
    {
      int rs = -1;
      if (s == 0) rs = 12; else { int q = (s - 1) % STEPS_PER_GROUP; rs = (q == 0) ? 11 : (q - 1) % STEPS_PER_LAYER; }
      if ((REPEAT_MASK >> rs) & 1) { grid.sync(); run_step(P, s, lds); }
    }
#endif
#if EXTRA_SYNC
    grid.sync();
#endif
    if (s + 1 < P.step_hi) { if (s == 0) grid.sync(); else xcd_barrier(xb); }
  }
}

extern "C" void kernel_launch(void* const* d_in, const int* in_sizes, int n_in, void* d_out, int out_size, void* d_ws, size_t ws_size,
                              hipStream_t stream) {
  static int grid_blocks = 0;
  if (!grid_blocks) {
    int dev = 0, cus = 0, per_cu = 0;
    hipGetDevice(&dev);
    hipDeviceGetAttribute(&cus, hipDeviceAttributeMultiprocessorCount, dev);
    hipFuncSetAttribute((const void*)fwd_megakernel, hipFuncAttributeMaxDynamicSharedMemorySize, LDS_BYTES);
    hipOccupancyMaxActiveBlocksPerMultiprocessor(&per_cu, (const void*)fwd_megakernel, NT, LDS_BYTES);
    if (per_cu < 1) per_cu = 1;
    grid_blocks = cus * per_cu;
    if (ws_size < WS_END) fprintf(stderr, "workspace too small: %zu < %zu\n", ws_size, (size_t)WS_END);
  }
  Params p{};
  for (int i = 0; i < 31; ++i) p.in[i] = (const float*)d_in[i];
  p.out = (float*)d_out; p.ws = (unsigned char*)d_ws;
#if MULTI_LAUNCH
  for (int s = 0; s < N_STEPS; ++s) {
    p.step_lo = s; p.step_hi = s + 1;
    hipLaunchKernelGGL(fwd_megakernel, dim3(grid_blocks), dim3(NT), LDS_BYTES, stream, p);
  }
#else
  p.step_lo = 0; p.step_hi = N_STEPS;
  (void)hipMemsetAsync((char*)d_ws + OFF_BAR, 0, XCD_BAR_WORDS * sizeof(unsigned), stream);
  void* args[] = {&p};
  hipError_t e = hipLaunchCooperativeKernel((const void*)fwd_megakernel, dim3(grid_blocks), dim3(NT), args, LDS_BYTES, stream);
  if (e != hipSuccess) fprintf(stderr, "cooperative launch failed: %s (grid %d)\n", hipGetErrorString(e), grid_blocks);
#endif
}
```

```cpp
#include <hip/hip_runtime.h>
#include <hip/hip_cooperative_groups.h>
#include <cstdio>
namespace cg = cooperative_groups;

typedef unsigned short bf16_t;
using bf16x8 = __attribute__((ext_vector_type(8))) short;
using f32x16 = __attribute__((ext_vector_type(16))) float;
#define DI __device__ __forceinline__
#define MFMA(a, b, c) __builtin_amdgcn_mfma_f32_32x32x16_bf16((a), (b), (c), 0, 0, 0)

#ifndef MULTI_LAUNCH
#define MULTI_LAUNCH 0
#endif
#ifndef REPEAT_MASK
#define REPEAT_MASK 0
#ifndef REPEAT_ATT
#define REPEAT_ATT 0
#endif
#ifndef REPEAT_SCAN
#define REPEAT_SCAN 0
#endif
#endif
#ifndef PROBE_EPI2
#define PROBE_EPI2 0
#endif
#ifndef EXTRA_SYNC
#define EXTRA_SYNC 0
#endif

constexpr int NT = 512;
constexpr int SEQ = 2048, D = 1024;
constexpr int GSEQ = 16;
constexpr int TG = GSEQ * SEQ;
constexpr int NGROUP = 3;
constexpr int NSEQ_ALL = 48;
constexpr int DEPTH = 2;
constexpr int N_IN = 6928, N_INP = 7168;
constexpr int LDP = 6912;
constexpr int P_XM = 0, P_Z = 1024, P_AQ = 2048, P_AK = 2560, P_AV = 2688, P_U = 2816, P_V = 3328, P_G = 3840;
constexpr float ALPHA = 1.4142135623730951f;
constexpr float LN_EPS = 1e-5f;

enum { I_XP = 0, I_XS, I_CP, I_CS, I_ADAW, I_ADAB, I_WIN, I_BIN, I_CONVW, I_CONVB, I_WQ, I_WK, I_WV, I_NORMW, I_SINK,
       I_CLNW, I_CLNB, I_CWS, I_CBS, I_PM, I_PA, I_PC, I_WOUT, I_LN1W, I_LN1B, I_W1, I_B1, I_W2, I_B2, I_LN2W, I_LN2B };

constexpr size_t W_IN = 0, W_QKV = 7340032, W_PM = 8126464, W_PA = 9175040  , W_PC = W_PA + 512, W_OUT = 10223616,
                 W_1 = 11272192, W_2 = 15466496, W_LAYER = 19660800;
constexpr size_t MiB = 1u << 20;
constexpr size_t OFF_W = 0;
constexpr size_t OFF_MOD = 80 * MiB;
constexpr size_t OFF_BINP = 83 * MiB;
constexpr size_t OFF_R0 = 84 * MiB;
constexpr size_t OFF_R2 = 148 * MiB;
constexpr size_t OFF_R1 = 212 * MiB;
constexpr size_t OFF_R3 = 644 * MiB;
constexpr size_t OFF_R5 = 900 * MiB;
constexpr size_t OFF_GATES = 964 * MiB;
constexpr size_t OFF_GPRE = 966 * MiB;
constexpr size_t OFF_BAR = 970 * MiB;
constexpr size_t WS_END = 971 * MiB;

constexpr int LDS_WORK = 150 * 1024;
constexpr int LDS_BYTES = LDS_WORK + 64;

struct Params {
  const float* in[31];
  float* out;
  unsigned char* ws;
  int step_lo, step_hi;
};

typedef __bf16 bf2_t __attribute__((ext_vector_type(2)));
typedef float f2_t __attribute__((ext_vector_type(2)));
DI bf16_t f2bf(float x) { return __builtin_bit_cast(unsigned short, (__bf16)x); }
DI float bf2f(bf16_t b) { return __uint_as_float(((unsigned)b) << 16); }
DI unsigned pack2(float a, float b) { f2_t v = {a, b}; return __builtin_bit_cast(unsigned, __builtin_convertvector(v, bf2_t)); }
DI float lo2f(unsigned u) { return __uint_as_float(u << 16); }
DI float hi2f(unsigned u) { return __uint_as_float(u & 0xffff0000u); }
DI int crow(int e, int h) { return (e & 3) + 8 * (e >> 2) + 4 * h; }
DI float sigmoidf_(float x) { return __builtin_amdgcn_rcpf(1.f + __builtin_amdgcn_exp2f(-1.4426950408889634f * x)); }
DI float gelu_tanh(float x) {
  const float u2 = 1.5957691216057308f * (x + 0.044715f * x * x * x);
  return x * __builtin_amdgcn_rcpf(1.f + __builtin_amdgcn_exp2f(-1.4426950408889634f * u2));
}
template <int M> DI float sx(float v) { return __int_as_float(__builtin_amdgcn_ds_swizzle(__float_as_int(v), (M << 10) | 0x1F)); }
DI float bperm(int src_lane, float v) { return __int_as_float(__builtin_amdgcn_ds_bpermute(src_lane << 2, __float_as_int(v))); }
DI float wsum(float v, int lane) { v += sx<1>(v); v += sx<2>(v); v += sx<4>(v); v += sx<8>(v); v += sx<16>(v); v += bperm(lane ^ 32, v); return v; }

#define LAS __attribute__((address_space(3)))
using f32x4 = __attribute__((ext_vector_type(4))) float;
constexpr int GBK = 64, GHALF = 128, HTB = GHALF * GBK * 2;
DI int lds_byte(int r, int c) { const int st = (r >> 4) * 2 + (c >> 5), rr = r & 15, cc = c & 31, ob = rr * 64 + cc * 2; return st * 1024 + (ob ^ (((ob >> 9) & 1) << 5)); }
DI void stage_rc(int b, int& R, int& C) { const int st = b / 1024, sb = b % 1024, swz = sb ^ (((sb >> 9) & 1) << 5); R = (st >> 1) * 16 + swz / 64; C = (st & 1) * 32 + (swz % 64) / 2; }
DI int perm32(int rho) { const int n = rho >> 4, i = rho & 15; return 8 * (i >> 2) + 4 * n + (i & 3); }
struct GUnit { const char* A; const char* B; int nt, pm, pn, tag; };
typedef f32x4 GAcc[2][2][4][2];

DI void static_unit(int L, int nM, int nN, int& pm, int& pn) {
  const int nwg = nM * nN;
  int wgid = L; { const int q = nwg / 8, r = nwg % 8, xcd = wgid % 8, off = wgid / 8; wgid = (xcd < r ? xcd * (q + 1) : r * (q + 1) + (xcd - r) * q) + off; }
  const int nig = 8 * nN, gid = wgid / nig, fm = gid * 8, gsz = (nM - fm) < 8 ? (nM - fm) : 8;
  pm = fm + ((wgid % nig) % gsz); pn = (wgid % nig) / gsz;
}

template <class Sched, class Epi>
DI void gemm_phase8(bf16_t* lds_generic, int lda, int ldb, const Sched& S, const Epi& E, int tid) {
  LAS unsigned char* lds = (LAS unsigned char*)lds_generic;
  const int wid = __builtin_amdgcn_readfirstlane(tid >> 6), lane = tid & 63, wr = wid >> 2, wc = wid & 3, fr = lane & 15, fq = lane >> 4;
  unsigned voffA[2], voffB[2];
#pragma unroll
  for (int i = 0; i < 2; ++i) { int R, C; stage_rc(tid * 16 + i * 8192, R, C); const int Rb = (R & ~31) + perm32(R & 31);
    voffA[i] = (unsigned)(R * lda + C) * 2u; voffB[i] = (unsigned)(Rb * ldb + C) * 2u; }
  const size_t kstep = (size_t)(GBK * 2);
  const size_t hstepA = (size_t)GHALF * lda * 2, hstepB = (size_t)GHALF * ldb * 2;
  const unsigned ldsw = (unsigned)wid * 1024u;
  const int aoff = lds_byte(wr * 64 + fr, fq * 8), boff = lds_byte(wc * 32 + fr, fq * 8);
#define PG8_SA(b, h) (((b) * 2 + (h)) * HTB)
#define PG8_SB(b, h) ((4 + (b) * 2 + (h)) * HTB)
#define PG8_STAGE(bufoff, gbase, voff) do { _Pragma("unroll") for (int _i = 0; _i < 2; ++_i) \
    __builtin_amdgcn_global_load_lds((const unsigned*)((const char*)(gbase) + (voff)[_i]), (LAS unsigned*)(lds + (bufoff) + ldsw + _i * 8192), 16, 0, 0); } while (0)
#define PG8_LDA(dst, b, h) do { _Pragma("unroll") for (int m = 0; m < 4; ++m) _Pragma("unroll") for (int k = 0; k < 2; ++k) dst[m][k] = *(const LAS bf16x8*)(lds + PG8_SA(b, h) + aoff + m * 2048 + k * 1024); } while (0)
#define PG8_LDB(dst, b, h) do { _Pragma("unroll") for (int n = 0; n < 2; ++n) _Pragma("unroll") for (int k = 0; k < 2; ++k) dst[n][k] = *(const LAS bf16x8*)(lds + PG8_SB(b, h) + boff + n * 2048 + k * 1024); } while (0)
#define PG8_MMA(ai, bj, At, Bt) do { __builtin_amdgcn_s_setprio(1); _Pragma("unroll") for (int m = 0; m < 4; ++m) _Pragma("unroll") for (int n = 0; n < 2; ++n) _Pragma("unroll") for (int k = 0; k < 2; ++k) \
    acc[ai][bj][m][n] = __builtin_amdgcn_mfma_f32_16x16x32_bf16(Bt[n][k], At[m][k], acc[ai][bj][m][n], 0, 0, 0); __builtin_amdgcn_s_setprio(0); } while (0)
#define PG8_WAIT_V(n) asm volatile("s_waitcnt vmcnt(" #n ")" ::: "memory")
#define PG8_WAIT_L(n) asm volatile("s_waitcnt lgkmcnt(" #n ")" ::: "memory")
#define PG8_BAR __builtin_amdgcn_s_barrier()
#define PG8_SCHED __builtin_amdgcn_sched_barrier(0)
  GUnit cur, nxt; int ui = 0;
  if (!S(0, cur)) return;
  GAcc acc;
#pragma unroll
  for (int a = 0; a < 2; ++a)
#pragma unroll
    for (int b = 0; b < 2; ++b)
#pragma unroll
      for (int m = 0; m < 4; ++m)
#pragma unroll
        for (int n = 0; n < 2; ++n) acc[a][b][m][n] = (f32x4){0.f, 0.f, 0.f, 0.f};
  bf16x8 At[4][2], B0[2][2], B1[2][2];
  const char* cA = cur.A; const char* cB = cur.B;
  PG8_STAGE(PG8_SB(0, 0), cB, voffB); PG8_STAGE(PG8_SA(0, 0), cA, voffA); PG8_STAGE(PG8_SB(0, 1), cB + hstepB, voffB); PG8_STAGE(PG8_SA(0, 1), cA + hstepA, voffA);
  if (wr == 1) PG8_BAR;
  PG8_WAIT_V(4); PG8_BAR;
  PG8_STAGE(PG8_SB(1, 0), cB + kstep, voffB); PG8_STAGE(PG8_SA(1, 0), cA + kstep, voffA); PG8_STAGE(PG8_SB(1, 1), cB + hstepB + kstep, voffB);
  PG8_WAIT_V(6); PG8_BAR;
  for (;;) {
    const bool has_next = S(ui + 1, nxt);
    const char* nA = has_next ? nxt.A : cA; const char* nB = has_next ? nxt.B : cB;
    const int nt = cur.nt;
#pragma unroll 1
    for (int t = 0; t < nt; t += 2) {
      const bool last = (t == nt - 2);
      const char* a1 = cA + (size_t)(t + 1) * kstep;
      const char* a2 = last ? nA : cA + (size_t)(t + 2) * kstep; const char* b2 = last ? nB : cB + (size_t)(t + 2) * kstep;
      const char* a3 = a2 + kstep; const char* b3 = b2 + kstep;
      PG8_LDB(B0, 0, 0); PG8_SCHED; PG8_LDA(At, 0, 0); PG8_STAGE(PG8_SA(1, 1), a1 + hstepA, voffA);
      PG8_WAIT_L(8); PG8_BAR; PG8_WAIT_L(0); PG8_MMA(0, 0, At, B0); PG8_BAR; PG8_SCHED;
      PG8_LDB(B1, 0, 1); PG8_STAGE(PG8_SB(0, 0), b2, voffB);
      PG8_BAR; PG8_WAIT_L(0); PG8_MMA(0, 1, At, B1); PG8_BAR;
      PG8_LDA(At, 0, 1); PG8_STAGE(PG8_SA(0, 0), a2, voffA);
      PG8_BAR; PG8_WAIT_L(0); PG8_MMA(1, 0, At, B0); PG8_BAR; PG8_SCHED;
      PG8_STAGE(PG8_SB(0, 1), b2 + hstepB, voffB);
      PG8_WAIT_V(6); PG8_BAR; PG8_MMA(1, 1, At, B1); PG8_BAR;
      PG8_LDB(B0, 1, 0); PG8_SCHED; PG8_LDA(At, 1, 0); PG8_STAGE(PG8_SA(0, 1), a2 + hstepA, voffA);
      PG8_WAIT_L(8); PG8_BAR; PG8_WAIT_L(0); PG8_MMA(0, 0, At, B0); PG8_BAR; PG8_SCHED;
      PG8_LDB(B1, 1, 1); PG8_STAGE(PG8_SB(1, 0), b3, voffB);
      PG8_BAR; PG8_WAIT_L(0); PG8_MMA(0, 1, At, B1); PG8_BAR;
      PG8_LDA(At, 1, 1); PG8_STAGE(PG8_SA(1, 0), a3, voffA);
      PG8_BAR; PG8_WAIT_L(0); PG8_MMA(1, 0, At, B0); PG8_BAR; PG8_SCHED;
      PG8_STAGE(PG8_SB(1, 1), b3 + hstepB, voffB);
      PG8_WAIT_V(6); PG8_BAR; PG8_MMA(1, 1, At, B1); PG8_BAR;
    }
    const bool keep = E(acc, cur, wr, wc, fr, fq);
#if PROBE_EPI2
    if (!keep) E(acc, cur, wr, wc, fr, fq);
#endif
    if (!has_next) break;
    if (!keep)
#pragma unroll
    for (int a = 0; a < 2; ++a)
#pragma unroll
      for (int b = 0; b < 2; ++b)
#pragma unroll
        for (int m = 0; m < 4; ++m)
#pragma unroll
          for (int n = 0; n < 2; ++n) acc[a][b][m][n] = (f32x4){0.f, 0.f, 0.f, 0.f};
    cur = nxt; cA = nA; cB = nB; ++ui;
  }
  PG8_WAIT_V(0);
  if (wr == 0) PG8_BAR;
  PG8_BAR;
#undef PG8_SA
#undef PG8_SB
#undef PG8_STAGE
#undef PG8_LDA
#undef PG8_LDB
#undef PG8_MMA
#undef PG8_WAIT_V
#undef PG8_WAIT_L
#undef PG8_BAR
#undef PG8_SCHED
}

template <class F> DI void for_rows8(const GAcc& acc, int wr, int wc, int fr, int fq, F f) {
#pragma unroll
  for (int ai = 0; ai < 2; ++ai)
#pragma unroll
    for (int m = 0; m < 4; ++m)
#pragma unroll
      for (int bj = 0; bj < 2; ++bj) f(ai * 128 + wr * 64 + m * 16 + fr, bj * 128 + wc * 32 + 8 * fq, acc[ai][bj][m][0], acc[ai][bj][m][1]);
}
template <class F> DI void for_rows8b(const GAcc& acc, int wr, int wc, int fr, int fq, F f) {
#pragma unroll
  for (int ai = 0; ai < 2; ++ai)
#pragma unroll
    for (int m = 0; m < 4; ++m)
#pragma unroll
      for (int bj = 0; bj < 2; ++bj) f(ai * 128 + wr * 64 + m * 16 + fr, bj * 128 + wc * 32 + 8 * fq, bj, acc[ai][bj][m][0], acc[ai][bj][m][1]);
}
struct ColVec { f32x4 v[2][2]; };
DI ColVec load_cols(const float* p, int wc, int fq) {
  ColVec c;
#pragma unroll
  for (int bj = 0; bj < 2; ++bj)
#pragma unroll
    for (int n = 0; n < 2; ++n) c.v[bj][n] = *(const f32x4*)(p + bj * 128 + wc * 32 + 8 * fq + 4 * n);
  return c;
}
DI uint4 pack8(f32x4 a, f32x4 b) { uint4 o; o.x = pack2(a[0], a[1]); o.y = pack2(a[2], a[3]); o.z = pack2(b[0], b[1]); o.w = pack2(b[2], b[3]); return o; }

struct Ctx {
  const Params* p;
  int g, l;
  int tid, bid, nb;
  unsigned char* wsp;
  bf16_t* lds;
  DI const float* in(int i) const { int ii = i; asm volatile("" : "+s"(ii)); return p->in[ii]; }
  DI unsigned char* ws() const { return wsp; }
  DI const bf16_t* W(size_t off) const { return (const bf16_t*)(wsp + OFF_W) + (size_t)l * W_LAYER + off; }
  DI const float* mod(int which, int seq_local) const {
    return (const float*)(wsp + OFF_MOD) + ((size_t)(l * NSEQ_ALL + g * GSEQ + seq_local)) * 6144 + which * 1024;
  }
  DI const float* xin() const {
    if (l == 0) return (g < 2) ? in(I_XP) + (size_t)g * TG * D : in(I_XS);
    return p->out + (size_t)g * TG * D;
  }
  DI float* xout() const { return p->out + (size_t)g * TG * D; }
};

DI void transpose_tile(const float* __restrict__ src, int ldsrc, int k0, int srccol0, int nvalid, bf16_t* __restrict__ dst, int lddst,
                       int n0, float scale, float* lds, int tid) {
  {
    const int n = tid & 63, kk = tid >> 6;
#pragma unroll
    for (int i = 0; i < 8; ++i) {
      const int k = kk + 8 * i;
      lds[k * 65 + n] = (n < nvalid) ? src[(size_t)(k0 + k) * ldsrc + srccol0 + n] : 0.f;
    }
  }
  __syncthreads();
  {
    const int k = tid & 63, nn = tid >> 6;
#pragma unroll
    for (int i = 0; i < 8; ++i) {
      const int n = nn + 8 * i;
      dst[(size_t)(n0 + n) * lddst + k0 + k] = f2bf(lds[k * 65 + n] * scale);
    }
  }
  __syncthreads();
}

DI void prep_item(const Params& P, int item, bf16_t* ldsb, int tid) {
  float* lds = (float*)ldsb;
  constexpr int PER_LAYER = 4800;
  if (item < 2 * PER_LAYER) {
    const int l = item / PER_LAYER; int it = item - l * PER_LAYER;
    bf16_t* wb = (bf16_t*)(P.ws + OFF_W) + (size_t)l * W_LAYER;
    if (it < 1792) {
      const int ntile = it >> 4, kt = it & 15;
      const int n0 = ntile * 64;
      int srccol0, nvalid;
      if (n0 < 2048) { srccol0 = n0; nvalid = 64; }
      else if (n0 < 6912) { srccol0 = n0 + 16; nvalid = 64; }
      else if (n0 == 6912) { srccol0 = 2048; nvalid = 16; }
      else { srccol0 = 0; nvalid = 0; }
      transpose_tile(P.in[I_WIN] + (size_t)l * 1024 * N_IN, N_IN, kt * 64, srccol0, nvalid, wb + W_IN, 1024, n0, 1.f, lds, tid);
      return;
    }
    it -= 1792;
    if (it < 192) {
      const int mh = it >> 4, tt = it & 15;
      const int which = mh >> 2, head = mh & 3;
      const float* src = P.in[I_WQ + which] + ((size_t)(l * 4 + head)) * 65536;
      transpose_tile(src, 256, (tt & 3) * 64, (tt >> 2) * 64, 64, wb + W_QKV + (size_t)mh * 65536, 256, (tt >> 2) * 64,
                     which == 1 ? 0.0625f : 1.f, lds, tid);
      return;
    }
    it -= 192;
    if (it < 256) { transpose_tile(P.in[I_PM] + (size_t)l * 1024 * 1024, 1024, (it & 15) * 64, (it >> 4) * 64, 64, wb + W_PM, 1024, (it >> 4) * 64, 1.f, lds, tid); return; }
    it -= 256;
    if (it < 128) { transpose_tile(P.in[I_PA] + (size_t)l * 512 * 1024, 1024, (it & 7) * 64, (it >> 3) * 64, 64, wb + W_PA, 1024, (it >> 3) * 64, 1.f, lds, tid); return; }
    it -= 128;
    if (it < 128) { transpose_tile(P.in[I_PC] + (size_t)l * 512 * 1024, 1024, (it & 7) * 64, (it >> 3) * 64, 64, wb + W_PC, 1024, (it >> 3) * 64, 1.f, lds, tid); return; }
    it -= 128;
    if (it < 256) { transpose_tile(P.in[I_WOUT] + (size_t)l * 1024 * 1024, 1024, (it & 15) * 64, (it >> 4) * 64, 64, wb + W_OUT, 1024, (it >> 4) * 64, 1.f, lds, tid); return; }
    it -= 256;
    if (it < 1024) { transpose_tile(P.in[I_W1] + (size_t)l * 1024 * 4096, 4096, (it & 15) * 64, (it >> 4) * 64, 64, wb + W_1, 1024, (it >> 4) * 64, 1.f, lds, tid); return; }
    it -= 1024;
    transpose_tile(P.in[I_W2] + (size_t)l * 4096 * 1024, 1024, (it & 63) * 64, (it >> 6) * 64, 64, wb + W_2, 4096, (it >> 6) * 64, 1.f, lds, tid);
    return;
  }
  item -= 2 * PER_LAYER;
  if (item < 2) {
    const int l = item;
    float* bp = (float*)(P.ws + OFF_BINP) + l * N_INP;
    const float* b = P.in[I_BIN] + (size_t)l * N_IN;
    for (int n = tid; n < N_INP; n += NT) {
      float v = 0.f;
      if (n < 2048) v = b[n]; else if (n < 6912) v = b[n + 16]; else if (n < 6928) v = b[2048 + n - 6912];
      bp[n] = v;
    }
    return;
  }
  item -= 2;
  {
    const int bh = item & 1, cc = (item >> 1) % 48, l = item / 96;
    for (int idx = tid; idx < 1024 * 24; idx += NT) {
      const int k = idx / 24, b = idx - k * 24, bg = bh * 24 + b;
      const float c = (bg < 32) ? P.in[I_CP][bg * 1024 + k] : P.in[I_CS][(bg - 32) * 1024 + k];
      lds[idx] = c / (1.f + __expf(-c));
    }
    __syncthreads();
    const int cl = tid & 127, kq = tid >> 7, col = cc * 128 + cl;
    float acc[24];
#pragma unroll
    for (int b = 0; b < 24; ++b) acc[b] = 0.f;
    const float* w = P.in[I_ADAW] + (size_t)l * 1024 * 6144 + col;
    for (int k = kq * 256; k < kq * 256 + 256; ++k) {
      const float wv = w[(size_t)k * 6144];
      const float4* s4 = (const float4*)(lds + k * 24);
#pragma unroll
      for (int q = 0; q < 6; ++q) {
        const float4 s = s4[q];
        acc[4 * q] += wv * s.x; acc[4 * q + 1] += wv * s.y; acc[4 * q + 2] += wv * s.z; acc[4 * q + 3] += wv * s.w;
      }
    }
    __syncthreads();
#pragma unroll
    for (int b = 0; b < 24; ++b) lds[(kq * 24 + b) * 128 + cl] = acc[b];
    __syncthreads();
    float* mod = (float*)(P.ws + OFF_MOD);
    for (int idx = tid; idx < 24 * 128; idx += NT) {
      const int b = idx >> 7, c = idx & 127;
      const float v = lds[(0 * 24 + b) * 128 + c] + lds[(1 * 24 + b) * 128 + c] + lds[(2 * 24 + b) * 128 + c] + lds[(3 * 24 + b) * 128 + c] +
                      P.in[I_ADAB][l * 6144 + cc * 128 + c];
      mod[((size_t)(l * NSEQ_ALL + bh * 24 + b)) * 6144 + cc * 128 + c] = v;
    }
    __syncthreads();
  }
}
constexpr int PREP_ITEMS = 2 * 4800 + 2 + 192;

DI void phase_xm0(const Ctx& c) {
  const float* x = c.xin();
  bf16_t* xm = (bf16_t*)(c.ws() + OFF_R0);
  const size_t n8 = (size_t)TG * D / 8;
  for (size_t i = (size_t)c.bid * NT + c.tid; i < n8; i += (size_t)c.nb * NT) {
    const int row = (int)(i >> 7), col = (int)(i & 127) * 8;
    const float4 v0 = *(const float4*)(x + i * 8), v1 = *(const float4*)(x + i * 8 + 4);
    const float* scp = c.mod(1, row >> 11) + col; const float* shp = c.mod(0, row >> 11) + col;
    const float4 sc0 = *(const float4*)scp, sc1 = *(const float4*)(scp + 4), sh0 = *(const float4*)shp, sh1 = *(const float4*)(shp + 4);
    uint4 o;
    o.x = pack2(v0.x * (1.f + sc0.x) + sh0.x, v0.y * (1.f + sc0.y) + sh0.y); o.y = pack2(v0.z * (1.f + sc0.z) + sh0.z, v0.w * (1.f + sc0.w) + sh0.w);
    o.z = pack2(v1.x * (1.f + sc1.x) + sh1.x, v1.y * (1.f + sc1.y) + sh1.y); o.w = pack2(v1.z * (1.f + sc1.z) + sh1.z, v1.w * (1.f + sc1.w) + sh1.w);
    *(uint4*)(xm + i * 8) = o;
  }
}

DI void phase_conv(const Ctx& c) {
  const bf16_t* proj = (const bf16_t*)(c.ws() + OFF_R1);
  bf16_t* xc = (bf16_t*)(c.ws() + OFF_R2);
  float* wl = (float*)c.lds;
  for (int i = c.tid; i < 6 * 1024; i += NT) wl[i] = (i < 5120) ? c.in(I_CONVW)[(size_t)c.l * 5120 + i] : c.in(I_CONVB)[(size_t)c.l * 1024 + i - 5120];
  __syncthreads();
  const size_t n16 = (size_t)TG * 64, stride = (size_t)c.nb * NT;
  const int ch = (c.tid & 63) * 16;
  size_t i = (size_t)c.bid * NT + c.tid;
  uint4 v[5][2], nv[5][2];
  auto load_rows = [&](size_t idx, uint4 (&dst)[5][2]) {
    const int row = (int)(idx >> 6), s = row & (SEQ - 1);
#pragma unroll
    for (int tp = 0; tp < 5; ++tp) {
      const int ss = s + tp - 2;
      if (ss >= 0 && ss < SEQ) {
        const bf16_t* p = proj + (size_t)(row + tp - 2) * LDP + P_XM + ch;
        dst[tp][0] = *(const uint4*)p; dst[tp][1] = *(const uint4*)(p + 8);
      } else { dst[tp][0] = make_uint4(0, 0, 0, 0); dst[tp][1] = make_uint4(0, 0, 0, 0); }
    }
  };
  if (i < n16) load_rows(i, v);
  for (; i < n16; i += stride) {
    const int row = (int)(i >> 6);
    const bool more = i + stride < n16;
    if (more) load_rows(i + stride, nv);
    uint4 o[2];
#pragma unroll
    for (int hh = 0; hh < 2; ++hh) {
      float acc[8];
      const int c0 = ch + hh * 8;
      const float4 cb0 = *(const float4*)(wl + 5120 + c0), cb1 = *(const float4*)(wl + 5120 + c0 + 4);
      acc[0] = cb0.x; acc[1] = cb0.y; acc[2] = cb0.z; acc[3] = cb0.w; acc[4] = cb1.x; acc[5] = cb1.y; acc[6] = cb1.z; acc[7] = cb1.w;
#pragma unroll
      for (int tp = 0; tp < 5; ++tp) {
        const uint4 u = v[tp][hh];
        const float4 w0 = *(const float4*)(wl + tp * 1024 + c0), w1 = *(const float4*)(wl + tp * 1024 + c0 + 4);
        acc[0] += lo2f(u.x) * w0.x; acc[1] += hi2f(u.x) * w0.y; acc[2] += lo2f(u.y) * w0.z; acc[3] += hi2f(u.y) * w0.w;
        acc[4] += lo2f(u.z) * w1.x; acc[5] += hi2f(u.z) * w1.y; acc[6] += lo2f(u.w) * w1.z; acc[7] += hi2f(u.w) * w1.w;
      }
#pragma unroll
      for (int j = 0; j < 8; ++j) acc[j] = acc[j] * sigmoidf_(acc[j]);
      o[hh].x = pack2(acc[0], acc[1]); o[hh].y = pack2(acc[2], acc[3]); o[hh].z = pack2(acc[4], acc[5]); o[hh].w = pack2(acc[6], acc[7]);
    }
    *(uint4*)(xc + (size_t)row * 1024 + ch) = o[0]; *(uint4*)(xc + (size_t)row * 1024 + ch + 8) = o[1];
    if (more) {
#pragma unroll
      for (int tp = 0; tp < 5; ++tp) { v[tp][0] = nv[tp][0]; v[tp][1] = nv[tp][1]; }
    }
  }
  __syncthreads();
}

DI void phase_post(const Ctx& c) {
  const bf16_t* hf = (const bf16_t*)(c.ws() + OFF_R0);
  bf16_t* hb = (bf16_t*)(c.ws() + OFF_R2);
  const bf16_t* proj = (const bf16_t*)(c.ws() + OFF_R1);
  const float* nw = c.in(I_NORMW) + (size_t)c.l * 1024;
  const int lane = c.tid & 63;
  const int gw = c.bid * (NT / 64) + (c.tid >> 6), nw_ = c.nb * (NT / 64);
  float4 wv[4];
#pragma unroll
  for (int hd = 0; hd < 4; ++hd) wv[hd] = *(const float4*)(nw + hd * 256 + lane * 4);
  for (int idx0 = gw * 4; idx0 < TG * 4; idx0 += nw_ * 4) {
    uint2 a[4], b[4], z[4];
#pragma unroll
    for (int rr = 0; rr < 4; ++rr) {
      const int row = (idx0 + rr) >> 2, head = (idx0 + rr) & 3;
      const size_t base = (size_t)row * 1024 + head * 256 + lane * 4;
      a[rr] = *(const uint2*)(hf + base); b[rr] = *(const uint2*)(hb + base);
      z[rr] = *(const uint2*)(proj + (size_t)row * LDP + P_Z + head * 256 + lane * 4);
    }
#pragma unroll
    for (int rr = 0; rr < 4; ++rr) {
      const int row = (idx0 + rr) >> 2, head = (idx0 + rr) & 3;
      const size_t base = (size_t)row * 1024 + head * 256 + lane * 4;
      float x0 = lo2f(a[rr].x) + lo2f(b[rr].x), x1 = hi2f(a[rr].x) + hi2f(b[rr].x), x2 = lo2f(a[rr].y) + lo2f(b[rr].y), x3 = hi2f(a[rr].y) + hi2f(b[rr].y);
      const float mean = wsum(x0 + x1 + x2 + x3, lane) * (1.f / 256.f);
      x0 -= mean; x1 -= mean; x2 -= mean; x3 -= mean;
      const float var = wsum(x0 * x0 + x1 * x1 + x2 * x2 + x3 * x3, lane) * (1.f / 256.f);
      const float rstd = rsqrtf(var + LN_EPS);
      const float4 w = wv[rr];
      uint2 o;
      o.x = pack2(x0 * rstd * w.x * sigmoidf_(lo2f(z[rr].x)), x1 * rstd * w.y * sigmoidf_(hi2f(z[rr].x)));
      o.y = pack2(x2 * rstd * w.z * sigmoidf_(lo2f(z[rr].y)), x3 * rstd * w.w * sigmoidf_(hi2f(z[rr].y)));
      *(uint2*)(hb + base) = o;
    }
  }
}

DI void phase_ln(const Ctx& c, const bf16_t* pre, const float* xres, const float* w, const float* b, int mod_layer, int mod_sh, int mod_sc) {
  float* xo = c.xout();
  bf16_t* xm = (bf16_t*)(c.ws() + OFF_R0);
  const int lane = c.tid & 63;
  const int gw = c.bid * (NT / 64) + (c.tid >> 6), nw_ = c.nb * (NT / 64);
  float4 ww[4], bb[4];
#pragma unroll
  for (int i = 0; i < 4; ++i) { ww[i] = *(const float4*)(w + i * 256 + lane * 4); bb[i] = *(const float4*)(b + i * 256 + lane * 4); }
  for (int row0 = gw * 4; row0 < TG; row0 += nw_ * 4) {
    float4 v[4][4], sc[4], sh[4];
    const float* modbase = (const float*)(c.ws() + OFF_MOD) + ((size_t)((mod_layer < 0 ? 0 : mod_layer) * NSEQ_ALL + c.g * GSEQ + (row0 >> 11))) * 6144;
#pragma unroll
    for (int rr = 0; rr < 4; ++rr)
#pragma unroll
      for (int i = 0; i < 4; ++i) {
        const size_t off = (size_t)(row0 + rr) * 1024 + i * 256 + lane * 4;
        const uint2 pv = *(const uint2*)(pre + off); const float4 xv = *(const float4*)(xres + off);
        v[rr][i].x = ALPHA * xv.x + lo2f(pv.x); v[rr][i].y = ALPHA * xv.y + hi2f(pv.x); v[rr][i].z = ALPHA * xv.z + lo2f(pv.y); v[rr][i].w = ALPHA * xv.w + hi2f(pv.y);
      }
    if (mod_layer >= 0) {
#pragma unroll
      for (int i = 0; i < 4; ++i) { sc[i] = *(const float4*)(modbase + mod_sc * 1024 + i * 256 + lane * 4); sh[i] = *(const float4*)(modbase + mod_sh * 1024 + i * 256 + lane * 4); }
    }
#pragma unroll
    for (int rr = 0; rr < 4; ++rr) {
      float s = 0.f;
#pragma unroll
      for (int i = 0; i < 4; ++i) s += v[rr][i].x + v[rr][i].y + v[rr][i].z + v[rr][i].w;
      const float mean = wsum(s, lane) * (1.f / 1024.f);
      float q = 0.f;
#pragma unroll
      for (int i = 0; i < 4; ++i) { float4& t = v[rr][i]; t.x -= mean; t.y -= mean; t.z -= mean; t.w -= mean; q += t.x * t.x + t.y * t.y + t.z * t.z + t.w * t.w; }
      const float rstd = rsqrtf(wsum(q, lane) * (1.f / 1024.f) + LN_EPS);
#pragma unroll
      for (int i = 0; i < 4; ++i) {
        float4& t = v[rr][i];
        t.x = t.x * rstd * ww[i].x + bb[i].x; t.y = t.y * rstd * ww[i].y + bb[i].y; t.z = t.z * rstd * ww[i].z + bb[i].z; t.w = t.w * rstd * ww[i].w + bb[i].w;
      }
    }
    asm volatile("" ::: "memory");
#pragma unroll
    for (int rr = 0; rr < 4; ++rr)
#pragma unroll
      for (int i = 0; i < 4; ++i) {
        const size_t off = (size_t)(row0 + rr) * 1024 + i * 256 + lane * 4;
        const float4 y = v[rr][i];
        *(float4*)(xo + off) = y;
        if (mod_layer >= 0) {
          uint2 o; o.x = pack2(y.x * (1.f + sc[i].x) + sh[i].x, y.y * (1.f + sc[i].y) + sh[i].y); o.y = pack2(y.z * (1.f + sc[i].z) + sh[i].z, y.w * (1.f + sc[i].w) + sh[i].w);
          *(uint2*)(xm + off) = o;
        }
      }
  }
}

DI void phase_g1(const Ctx& c) {
  const char* xm = (const char*)(c.ws() + OFF_R0);
  bf16_t* proj = (bf16_t*)(c.ws() + OFF_R1);
  float* gates = (float*)(c.ws() + OFF_GATES);
  const float* binp = (const float*)(c.ws() + OFF_BINP) + c.l * N_INP;
  const char* wt = (const char*)c.W(W_IN);
  constexpr int nM = TG / 256, nN = N_INP / 256;
  auto sched = [&](int i, GUnit& u) -> bool {
    const int L = i * c.nb + c.bid; if (L >= nM * nN) return false;
    static_unit(L, nM, nN, u.pm, u.pn);
    u.A = xm + (size_t)u.pm * 256 * 1024 * 2; u.B = wt + (size_t)u.pn * 256 * 1024 * 2; u.nt = 16; u.tag = 0; return true; };
  auto epi = [&](GAcc& acc, const GUnit& u, int wr, int wc, int fr, int fq) -> bool {
    const int m0 = u.pm * 256, n0 = u.pn * 256;
    const ColVec bv = load_cols(binp + n0, wc, fq);
    if (n0 < P_U) {
      for_rows8b(acc, wr, wc, fr, fq, [&](int rl, int cl, int bj, f32x4 v0, f32x4 v1) {
        *(uint4*)(proj + (size_t)(m0 + rl) * LDP + n0 + cl) = pack8(v0 + bv.v[bj][0], v1 + bv.v[bj][1]); });
    } else if (n0 < P_G) {
      for_rows8b(acc, wr, wc, fr, fq, [&](int rl, int cl, int bj, f32x4 v0, f32x4 v1) {
        v0 += bv.v[bj][0]; v1 += bv.v[bj][1];
#pragma unroll
        for (int j = 0; j < 4; ++j) { v0[j] = gelu_tanh(v0[j]); v1[j] = gelu_tanh(v1[j]); }
        *(uint4*)(proj + (size_t)(m0 + rl) * LDP + n0 + cl) = pack8(v0, v1); });
    } else if (n0 < LDP) {
      for_rows8b(acc, wr, wc, fr, fq, [&](int rl, int cl, int bj, f32x4 v0, f32x4 v1) {
        v0 += bv.v[bj][0]; v1 += bv.v[bj][1];
#pragma unroll
        for (int j = 0; j < 4; ++j) { v0[j] = sigmoidf_(v0[j]); v1[j] = sigmoidf_(v1[j]); }
        *(uint4*)(proj + (size_t)(m0 + rl) * LDP + n0 + cl) = pack8(v0, v1); });
    } else {
      for_rows8b(acc, wr, wc, fr, fq, [&](int rl, int cl, int bj, f32x4 v0, f32x4 v1) {
        if (cl < 16) {
          float* o = gates + (size_t)(m0 + rl) * 16 + cl;
          *(f32x4*)o = v0 + bv.v[bj][0]; *(f32x4*)(o + 4) = v1 + bv.v[bj][1];
        } });
    }
    return false;
  };
  gemm_phase8(c.lds, 1024, 1024, sched, epi, c.tid);
}

DI void phase_g2(const Ctx& c) {
  const char* xc = (const char*)(c.ws() + OFF_R2);
  const char* proj = (const char*)(c.ws() + OFF_R1);
  bf16_t* mq = (bf16_t*)(c.ws() + OFF_R3);
  bf16_t* mk = mq + (size_t)TG * 1024;
  bf16_t* mkt = mk + (size_t)TG * 1024;
  bf16_t* mvt = mkt + (size_t)TG * 1024;
  const char* wqkv = (const char*)c.W(W_QKV);
  constexpr int nM = TG / 256;
  {
    auto sched = [&](int i, GUnit& u) -> bool {
      const int L = i * c.nb + c.bid; if (L >= nM * 8) return false;
      u.pm = L >> 3; u.pn = L & 3; u.tag = (L >> 2) & 1;
      u.A = xc + ((size_t)u.pm * 256 * 1024 + u.pn * 256) * 2; u.B = wqkv + (size_t)(u.tag * 4 + u.pn) * 65536 * 2; u.nt = 4; return true; };
    auto epi = [&](GAcc& acc, const GUnit& u, int wr, int wc, int fr, int fq) -> bool {
      bf16_t* dst = (u.tag ? mk : mq) + (size_t)u.pm * 256 * 1024 + u.pn * 256;
      for_rows8(acc, wr, wc, fr, fq, [&](int rl, int cl, f32x4 v0, f32x4 v1) { *(uint4*)(dst + (size_t)rl * 1024 + cl) = pack8(v0, v1); }); return false; };
    int t1 = c.tid; asm volatile("" : "+v"(t1));
    gemm_phase8(c.lds, 1024, 256, sched, epi, t1);
  }
  {
    auto sched = [&](int i, GUnit& u) -> bool {
      const int L = i * c.nb + c.bid; if (L >= nM * 4) return false;
      u.pm = L >> 2; u.pn = L & 3; u.tag = 0;
      u.A = wqkv + (size_t)(4 + u.pn) * 65536 * 2; u.B = xc + ((size_t)u.pm * 256 * 1024 + u.pn * 256) * 2; u.nt = 4; return true; };
    auto epi = [&](GAcc& acc, const GUnit& u, int wr, int wc, int fr, int fq) -> bool {
      const int tok0 = u.pm * 256, seq = tok0 >> 11, s0 = tok0 & (SEQ - 1);
      bf16_t* dst = mkt + ((size_t)(seq * 4 + u.pn) * 256) * SEQ + s0;
      for_rows8(acc, wr, wc, fr, fq, [&](int rl, int cl, f32x4 v0, f32x4 v1) { *(uint4*)(dst + (size_t)rl * SEQ + cl) = pack8(v0, v1); }); return false; };
    int t2 = c.tid; asm volatile("" : "+v"(t2));
    gemm_phase8(c.lds, 256, 1024, sched, epi, t2);
  }
  {
    auto sched = [&](int i, GUnit& u) -> bool {
      const int L = i * c.nb + c.bid; if (L >= nM * 4) return false;
      u.pm = L >> 2; u.pn = L & 3; u.tag = 0;
      u.A = wqkv + (size_t)(8 + u.pn) * 65536 * 2; u.B = proj + ((size_t)u.pm * 256 * LDP + P_XM + u.pn * 256) * 2; u.nt = 4; return true; };
    auto epi = [&](GAcc& acc, const GUnit& u, int wr, int wc, int fr, int fq) -> bool {
      const int tok0 = u.pm * 256, seq = tok0 >> 11, s0 = tok0 & (SEQ - 1);
      bf16_t* dst = mvt + ((size_t)(seq * 4 + u.pn) * 256) * SEQ + s0;
      for_rows8(acc, wr, wc, fr, fq, [&](int rl, int cl, f32x4 v0, f32x4 v1) { *(uint4*)(dst + (size_t)rl * SEQ + cl) = pack8(v0, v1); }); return false; };
    int t3 = c.tid; asm volatile("" : "+v"(t3));
    gemm_phase8(c.lds, 256, LDP, sched, epi, t3);
  }
}

DI void phase_merge(const Ctx& c) {
  const char* ym = (const char*)(c.ws() + OFF_R2);
  const char* yac = (const char*)(c.ws() + OFF_R5);
  const bf16_t* proj = (const bf16_t*)(c.ws() + OFF_R1);
  bf16_t* merged = (bf16_t*)(c.ws() + OFF_R3);
  const char* wpm = (const char*)c.W(W_PM);
  const char* wpa = (const char*)c.W(W_PA);
  constexpr int nM = TG / 256, nN = 4;
  auto sched = [&](int i, GUnit& u) -> bool {
    const int j = i / 3, b = i - j * 3;
    const int L = j * c.nb + c.bid; if (L >= nM * nN) return false;
    static_unit(L, nM, nN, u.pm, u.pn);
    u.tag = b; u.nt = (b == 0) ? 16 : 8;
    u.A = ((b == 0) ? ym : yac + (b == 2 ? 1024 : 0)) + (size_t)u.pm * 256 * 1024 * 2;
    u.B = ((b == 0) ? wpm : wpa + (b == 2 ? 1024 : 0)) + (size_t)u.pn * 256 * 1024 * 2;
    return true; };
  auto epi = [&](GAcc& acc, const GUnit& u, int wr, int wc, int fr, int fq) -> bool {
    const int m0 = u.pm * 256, n0 = u.pn * 256, b = u.tag;
    const bf16_t* gp = proj + (size_t)(m0 + wr * 64 + fr) * LDP + P_G + b * 1024 + n0 + wc * 32 + 8 * fq;
#pragma unroll
    for (int ai = 0; ai < 2; ++ai) {
      uint4 g[4][2], gn[4][2];
#pragma unroll
      for (int m = 0; m < 4; ++m)
#pragma unroll
        for (int bj = 0; bj < 2; ++bj) {
          const bf16_t* q = gp + (size_t)(ai * 128 + m * 16) * LDP + bj * 128;
          g[m][bj] = *(const uint4*)q;
          if (b < 2) gn[m][bj] = *(const uint4*)(q + 1024);
        }
#pragma unroll
      for (int m = 0; m < 4; ++m)
#pragma unroll
        for (int bj = 0; bj < 2; ++bj) {
          const uint4 gg = g[m][bj];
          f32x4 g0 = {lo2f(gg.x), hi2f(gg.x), lo2f(gg.y), hi2f(gg.y)}, g1 = {lo2f(gg.z), hi2f(gg.z), lo2f(gg.w), hi2f(gg.w)};
          if (b < 2) {
            const uint4 hh = gn[m][bj];
            const f32x4 h0 = {lo2f(hh.x), hi2f(hh.x), lo2f(hh.y), hi2f(hh.y)}, h1 = {lo2f(hh.z), hi2f(hh.z), lo2f(hh.w), hi2f(hh.w)};
#pragma unroll
            for (int j = 0; j < 4; ++j) { g0[j] *= __builtin_amdgcn_rcpf(fmaxf(h0[j], 1e-30f)); g1[j] *= __builtin_amdgcn_rcpf(fmaxf(h1[j], 1e-30f)); }
            acc[ai][bj][m][0] *= g0; acc[ai][bj][m][1] *= g1;
          } else {
            const size_t row = m0 + ai * 128 + wr * 64 + m * 16 + fr; const int col = n0 + bj * 128 + wc * 32 + 8 * fq;
            *(uint4*)(merged + row * 1024 + col) = pack8(g0 * acc[ai][bj][m][0], g1 * acc[ai][bj][m][1]);
          }
        }
    }
    return b < 2;
  };
  gemm_phase8(c.lds, 1024, 1024, sched, epi, c.tid);
}

DI void phase_wout(const Ctx& c) {
  const char* merged = (const char*)(c.ws() + OFF_R3);
  bf16_t* pre = (bf16_t*)(c.ws() + OFF_R3 + 64 * MiB);
  const char* wt = (const char*)c.W(W_OUT);
  constexpr int nM = TG / 256, nN = 4;
  auto sched = [&](int i, GUnit& u) -> bool {
    const int L = i * c.nb + c.bid; if (L >= nM * nN) return false;
    static_unit(L, nM, nN, u.pm, u.pn);
    u.A = merged + (size_t)u.pm * 256 * 1024 * 2; u.B = wt + (size_t)u.pn * 256 * 1024 * 2; u.nt = 16; u.tag = 0; return true; };
  auto epi = [&](GAcc& acc, const GUnit& u, int wr, int wc, int fr, int fq) -> bool {
    const int m0 = u.pm * 256, n0 = u.pn * 256;
    const ColVec gv = load_cols(c.mod(2, m0 >> 11) + n0, wc, fq);
    for_rows8b(acc, wr, wc, fr, fq, [&](int rl, int cl, int bj, f32x4 v0, f32x4 v1) {
      const size_t off = (size_t)(m0 + rl) * 1024 + n0 + cl;
      *(uint4*)(pre + off) = pack8((gv.v[bj][0] + 1.f) * v0, (gv.v[bj][1] + 1.f) * v1); }); return false; };
  gemm_phase8(c.lds, 1024, 1024, sched, epi, c.tid);
}

DI void phase_mlp1(const Ctx& c) {
  const char* xm = (const char*)(c.ws() + OFF_R0);
  bf16_t* hid = (bf16_t*)(c.ws() + OFF_R1);
  const float* b1 = c.in(I_B1) + (size_t)c.l * 4096;
  const char* wt = (const char*)c.W(W_1);
  constexpr int nM = TG / 256, nN = 16;
  auto sched = [&](int i, GUnit& u) -> bool {
    const int L = i * c.nb + c.bid; if (L >= nM * nN) return false;
    static_unit(L, nM, nN, u.pm, u.pn);
    u.A = xm + (size_t)u.pm * 256 * 1024 * 2; u.B = wt + (size_t)u.pn * 256 * 1024 * 2; u.nt = 16; u.tag = 0; return true; };
  auto epi = [&](GAcc& acc, const GUnit& u, int wr, int wc, int fr, int fq) -> bool {
    const int m0 = u.pm * 256, n0 = u.pn * 256;
    const ColVec bv = load_cols(b1 + n0, wc, fq);
    for_rows8b(acc, wr, wc, fr, fq, [&](int rl, int cl, int bj, f32x4 v0, f32x4 v1) {
      v0 += bv.v[bj][0]; v1 += bv.v[bj][1];
#pragma unroll
      for (int j = 0; j < 4; ++j) { const float a = fmaxf(v0[j], 0.f), b = fmaxf(v1[j], 0.f); v0[j] = a * a; v1[j] = b * b; }
      *(uint4*)(hid + (size_t)(m0 + rl) * 4096 + n0 + cl) = pack8(v0, v1); }); return false; };
  gemm_phase8(c.lds, 1024, 1024, sched, epi, c.tid);
}

DI void phase_mlp2(const Ctx& c) {
  const char* hid = (const char*)(c.ws() + OFF_R1);
  bf16_t* pre = (bf16_t*)(c.ws() + OFF_R1 + 256 * MiB);
  const float* b2 = c.in(I_B2) + (size_t)c.l * 1024;
  const char* wt = (const char*)c.W(W_2);
  constexpr int nM = TG / 256, nN = 4;
  auto sched = [&](int i, GUnit& u) -> bool {
    const int L = i * c.nb + c.bid; if (L >= nM * nN) return false;
    static_unit(L, nM, nN, u.pm, u.pn);
    u.A = hid + (size_t)u.pm * 256 * 4096 * 2; u.B = wt + (size_t)u.pn * 256 * 4096 * 2; u.nt = 64; u.tag = 0; return true; };
  auto epi = [&](GAcc& acc, const GUnit& u, int wr, int wc, int fr, int fq) -> bool {
    const int m0 = u.pm * 256, n0 = u.pn * 256;
    const ColVec gv = load_cols(c.mod(5, m0 >> 11) + n0, wc, fq), bv = load_cols(b2 + n0, wc, fq);
    for_rows8b(acc, wr, wc, fr, fq, [&](int rl, int cl, int bj, f32x4 v0, f32x4 v1) {
      const size_t off = (size_t)(m0 + rl) * 1024 + n0 + cl;
      *(uint4*)(pre + off) = pack8((gv.v[bj][0] + 1.f) * (v0 + bv.v[bj][0]), (gv.v[bj][1] + 1.f) * (v1 + bv.v[bj][1])); }); return false; };
  gemm_phase8(c.lds, 4096, 4096, sched, epi, c.tid);
}

DI void gate_prepass(const Ctx& c) {
  const float* gates = (const float*)(c.ws() + OFF_GATES);
  float* ga = (float*)(c.ws() + OFF_GPRE);
  float* gb = ga + 128 * SEQ; float* gc = gb + 128 * SEQ; float* gt = gc + 128 * SEQ;
  const int lane = c.tid & 63;
  const int gw = c.bid * (NT / 64) + (c.tid >> 6), nw_ = c.nb * (NT / 64);
  for (int idx = gw; idx < GSEQ * 4 * 2 * 32; idx += nw_) {
    const int cj = idx & 31, dir = (idx >> 5) & 1, head = (idx >> 6) & 3, seq = idx >> 8;
    const int p = dir ? 63 - lane : lane;
    const int t = seq * SEQ + cj * 64 + p;
    const float ig = gates[(size_t)t * 16 + dir * 8 + head];
    const float fg = gates[(size_t)t * 16 + dir * 8 + 4 + head];
    float a = fminf(fg, 0.f) - log1pf(__expf(-fabsf(fg)));
#pragma unroll
    for (int o = 1; o < 64; o <<= 1) { const float tt = bperm(lane - o, a); if (lane >= o) a += tt; }
    const float b = ig - a;
    float cmb = b;
#pragma unroll
    for (int o = 1; o < 64; o <<= 1) { const float tt = bperm(lane - o, cmb); if (lane >= o) cmb = fmaxf(cmb, tt); }
    const size_t base = (size_t)((seq * 4 + head) * 2 + dir) * SEQ + cj * 64 + p;
    ga[base] = a; gb[base] = b; gc[base] = cmb;
    if (lane == 63) { float* g2 = gt + ((seq * 4 + head) * 2 + dir) * 64 + cj * 2; g2[0] = a; g2[1] = cmb; }
  }
}

#define MFMA16(a, b, c) __builtin_amdgcn_mfma_f32_16x16x32_bf16((a), (b), (c), 0, 0, 0)
DI bf16x8 frag_from(uint2 lo, uint2 hi) { uint4 u; u.x = lo.x; u.y = lo.y; u.z = hi.x; u.w = hi.y; return __builtin_bit_cast(bf16x8, u); }
DI bf16x8 frag_pack(f32x4 lo, f32x4 hi) { uint4 u; u.x = pack2(lo[0], lo[1]); u.y = pack2(lo[2], lo[3]); u.z = pack2(hi[0], hi[1]); u.w = pack2(hi[2], hi[3]); return __builtin_bit_cast(bf16x8, u); }

DI void scan_item(const Ctx& c, int item) {
  const int vh = item & 1, dir = (item >> 1) & 1, head = (item >> 2) & 3, seq = item >> 4;
  const int tid = c.tid, lane = tid & 63, wave = tid >> 6, n16 = lane & 15, q4 = lane >> 4;
  const bf16_t* mq = (const bf16_t*)(c.ws() + OFF_R3);
  const bf16_t* mk = mq + (size_t)TG * 1024;
  const bf16_t* mkt = mk + (size_t)TG * 1024;
  const bf16_t* mvt = mkt + (size_t)TG * 1024;
  const float* gpre = (const float*)(c.ws() + OFF_GPRE);
  bf16_t* hout = (bf16_t*)(c.ws() + (dir ? OFF_R2 : OFF_R0));
  bf16_t* Qs = c.lds;
  bf16_t* Ks = Qs + 16896;
  bf16_t* KTs = Ks + 16896;
  bf16_t* VT = KTs + 18432;
  bf16_t* VTs = VT + 9216;
  bf16_t* Ps = VTs + 9216;
  float* fl = (float*)(Ps + 4608);
  float* ns = fl;
  float* abc_s = fl + 256;
  float* a_s = abc_s; float* b_s = abc_s + 64; float* c_s = abc_s + 128;
  float* wg_s = abc_s + 192; float* den_s = wg_s + 64; float* gt_s = den_s + 64; float* winter_s = gt_s + 64; float* emrow_s = winter_s + 64;

  f32x4 cst[16];
#pragma unroll
  for (int kt = 0; kt < 16; ++kt) cst[kt] = (f32x4){0.f, 0.f, 0.f, 0.f};
  float nreg = 0.f, mstate = 0.f;
  if (tid < 256) ns[tid] = 0.f;
  const int gidx = (seq * 4 + head) * 2 + dir;
  if (tid < 64) gt_s[tid] = gpre[(size_t)3 * 128 * SEQ + gidx * 64 + tid];
  const size_t tbase = (size_t)(seq * 4 + head) * 256;
  const int lrow = tid >> 5, lkc = (tid & 31) * 8;
  const bf16_t* qsrc = mq + (size_t)(seq * SEQ + lrow) * 1024 + head * 256 + lkc;
  const bf16_t* ksrc = mk + (size_t)(seq * SEQ + lrow) * 1024 + head * 256 + lkc;
  const bf16_t* vsrc = mvt + (tbase + vh * 128 + (tid >> 3)) * SEQ + (tid & 7) * 8;
  const bf16_t* ktsrc = mkt + (tbase + (tid >> 3)) * SEQ + (tid & 7) * 8;
  const float* gsrc = gpre + (size_t)(tid >> 6) * 128 * SEQ + (size_t)gidx * SEQ + (tid & 63);
  uint4 rq0, rq1, rq2, rq3, rk0, rk1, rk2, rk3, rt0, rt1, rt2, rt3, rv0, rv1; float rg = 0.f;
#define PF_QK(cn) do { const size_t o_ = (size_t)(cn) * 64 * 1024; \
    rq0 = *(const uint4*)(qsrc + o_); rq1 = *(const uint4*)(qsrc + o_ + 16 * 1024); rq2 = *(const uint4*)(qsrc + o_ + 32 * 1024); rq3 = *(const uint4*)(qsrc + o_ + 48 * 1024); \
    rk0 = *(const uint4*)(ksrc + o_); rk1 = *(const uint4*)(ksrc + o_ + 16 * 1024); rk2 = *(const uint4*)(ksrc + o_ + 32 * 1024); rk3 = *(const uint4*)(ksrc + o_ + 48 * 1024); } while (0)
#define PF_TV(cn) do { \
    rt0 = *(const uint4*)(ktsrc + (cn) * 64); rt1 = *(const uint4*)(ktsrc + (size_t)64 * SEQ + (cn) * 64); \
    rt2 = *(const uint4*)(ktsrc + (size_t)128 * SEQ + (cn) * 64); rt3 = *(const uint4*)(ktsrc + (size_t)192 * SEQ + (cn) * 64); \
    rv0 = *(const uint4*)(vsrc + (cn) * 64); rv1 = *(const uint4*)(vsrc + (size_t)64 * SEQ + (cn) * 64); \
    if (tid < 192) rg = gsrc[(cn) * 64]; } while (0)
#define PUT_QK() do { bf16_t* qd = Qs + lrow * 264 + lkc; bf16_t* kd = Ks + lrow * 264 + lkc; \
    *(uint4*)(qd) = rq0; *(uint4*)(qd + 16 * 264) = rq1; *(uint4*)(qd + 32 * 264) = rq2; *(uint4*)(qd + 48 * 264) = rq3; \
    *(uint4*)(kd) = rk0; *(uint4*)(kd + 16 * 264) = rk1; *(uint4*)(kd + 32 * 264) = rk2; *(uint4*)(kd + 48 * 264) = rk3; } while (0)
  PF_QK(dir ? 31 : 0); PF_TV(dir ? 31 : 0);
  PUT_QK();
  __syncthreads();

#pragma unroll 1
  for (int j = 0; j < 32; ++j) {
    const int cj = dir ? 31 - j : j;
    const int t0 = seq * SEQ + cj * 64;
    const float Atot = gt_s[cj * 2], cmbl = gt_s[cj * 2 + 1];
    const float m_new = Atot + fmaxf(mstate, cmbl);
    const float decay = __expf(Atot + mstate - m_new);
    {
      bf16_t* kw = KTs + (tid >> 3) * 72 + (tid & 7) * 8;
      *(uint4*)(kw) = rt0; *(uint4*)(kw + 64 * 72) = rt1; *(uint4*)(kw + 128 * 72) = rt2; *(uint4*)(kw + 192 * 72) = rt3;
      bf16_t* vw = VT + (tid >> 3) * 72 + (tid & 7) * 8;
      *(uint4*)(vw) = rv0; *(uint4*)(vw + 64 * 72) = rv1;
      if (tid < 192) abc_s[tid] = rg;
      if (tid >= 128 && tid < 192) winter_s[tid - 128] = __expf(mstate - fmaxf(mstate, rg));
    }
    __syncthreads();
    {
      const int sc = (tid & 7) * 8;
      const float4 q0 = *(const float4*)(b_s + sc), q1 = *(const float4*)(b_s + sc + 4);
      const float e0 = Atot - m_new;
      const float w0 = __expf(e0 + q0.x), w1 = __expf(e0 + q0.y), w2 = __expf(e0 + q0.z), w3 = __expf(e0 + q0.w);
      const float w4_ = __expf(e0 + q1.x), w5 = __expf(e0 + q1.y), w6 = __expf(e0 + q1.z), w7 = __expf(e0 + q1.w);
#pragma unroll
      for (int i = 0; i < 2; ++i) {
        const int v = (tid >> 3) + 64 * i;
        const uint4 raw = *(const uint4*)(VT + v * 72 + sc);
        uint4 o;
        o.x = pack2(lo2f(raw.x) * w0, hi2f(raw.x) * w1); o.y = pack2(lo2f(raw.y) * w2, hi2f(raw.y) * w3);
        o.z = pack2(lo2f(raw.z) * w4_, hi2f(raw.z) * w5); o.w = pack2(lo2f(raw.w) * w6, hi2f(raw.w) * w7);
        *(uint4*)(VTs + v * 72 + sc) = o;
      }
      if (tid < 64) { wg_s[tid] = __expf(e0 + b_s[tid]); emrow_s[tid] = __expf(-(a_s[tid] + fmaxf(mstate, c_s[tid]))); }
    }
    {
      const int lt = wave >> 1, st0 = (wave & 1) * 2;
      f32x4 sacc0 = {0.f, 0.f, 0.f, 0.f}, sacc1 = {0.f, 0.f, 0.f, 0.f};
      const bf16_t* ap = Qs + (16 * lt + n16) * 264 + 8 * q4;
      const bf16_t* bp = Ks + (16 * st0 + n16) * 264 + 8 * q4;
#pragma unroll
      for (int kk = 0; kk < 8; ++kk) {
        const bf16x8 a = *(const bf16x8*)(ap + 32 * kk);
        sacc0 = MFMA16(a, *(const bf16x8*)(bp + 32 * kk), sacc0);
        sacc1 = MFMA16(a, *(const bf16x8*)(bp + 16 * 264 + 32 * kk), sacc1);
      }
#pragma unroll
      for (int i = 0; i < 2; ++i) {
        const int scol = 16 * (st0 + i) + n16;
        const float bcol = b_s[scol];
#pragma unroll
        for (int jj = 0; jj < 4; ++jj) {
          const int lr = 16 * lt + 4 * q4 + jj;
          const bool valid = dir ? (scol >= lr) : (scol <= lr);
          const float sv = i ? sacc1[jj] : sacc0[jj];
          const float pv = valid ? sv * __expf(bcol - fmaxf(mstate, c_s[lr])) : 0.f;
          Ps[lr * 72 + scol] = f2bf(pv);
        }
      }
    }
    f32x4 iacc[4];
#pragma unroll
    for (int lt = 0; lt < 4; ++lt) iacc[lt] = (f32x4){0.f, 0.f, 0.f, 0.f};
#pragma unroll
    for (int kb = 0; kb < 8; ++kb) {
      const bf16x8 bfrag = frag_pack(cst[2 * kb], cst[2 * kb + 1]);
#pragma unroll
      for (int lt = 0; lt < 4; ++lt) {
        const bf16_t* qp = Qs + (16 * lt + n16) * 264 + 32 * kb + 4 * q4;
        iacc[lt] = MFMA16(frag_from(*(const uint2*)qp, *(const uint2*)(qp + 16)), bfrag, iacc[lt]);
      }
      __builtin_amdgcn_sched_barrier(0);
    }
#pragma unroll
    for (int lt = 0; lt < 4; ++lt) iacc[lt] *= *(const f32x4*)(winter_s + 16 * lt + 4 * q4);
    __syncthreads();
    if (j + 1 < 32) { PF_QK(dir ? cj - 1 : cj + 1); PF_TV(dir ? cj - 1 : cj + 1); }
#pragma unroll
    for (int ss = 0; ss < 2; ++ss) {
      const bf16x8 b = *(const bf16x8*)(VT + (16 * wave + n16) * 72 + 32 * ss + 8 * q4);
#pragma unroll
      for (int lt = 0; lt < 4; ++lt) iacc[lt] = MFMA16(*(const bf16x8*)(Ps + (16 * lt + n16) * 72 + 32 * ss + 8 * q4), b, iacc[lt]);
    }
    {
      const int l = tid >> 3, part = tid & 7;
      float qn = 0.f;
#pragma unroll
      for (int i = 0; i < 4; ++i) {
        const uint4 q = *(const uint4*)(Qs + l * 264 + part * 32 + i * 8);
        const float4 n0 = *(const float4*)(ns + part * 32 + i * 8), n1 = *(const float4*)(ns + part * 32 + i * 8 + 4);
        qn += lo2f(q.x) * n0.x + hi2f(q.x) * n0.y + lo2f(q.y) * n0.z + hi2f(q.y) * n0.w + lo2f(q.z) * n1.x + hi2f(q.z) * n1.y + lo2f(q.w) * n1.z +
              hi2f(q.w) * n1.w;
      }
      const uint4 pq = *(const uint4*)(Ps + l * 72 + part * 8);
      const float ps = lo2f(pq.x) + hi2f(pq.x) + lo2f(pq.y) + hi2f(pq.y) + lo2f(pq.z) + hi2f(pq.z) + lo2f(pq.w) + hi2f(pq.w);
      float tot = ps + winter_s[l] * qn;
      tot += sx<1>(tot); tot += sx<2>(tot); tot += sx<4>(tot);
      if (part == 0) den_s[l] = tot;
    }
    __syncthreads();
#pragma unroll
    for (int lt = 0; lt < 4; ++lt)
#pragma unroll
      for (int jj = 0; jj < 4; ++jj) {
        const int lr = 16 * lt + 4 * q4 + jj;
        const float d = fmaxf(fabsf(den_s[lr]), emrow_s[lr]);
        hout[(size_t)(t0 + lr) * 1024 + head * 256 + vh * 128 + 16 * wave + n16] = f2bf(iacc[lt][jj] * __builtin_amdgcn_rcpf(d));
      }
    if (tid < 256) {
      float s = 0.f;
#pragma unroll
      for (int i = 0; i < 8; ++i) {
        const uint4 q = *(const uint4*)(KTs + tid * 72 + i * 8);
        const float4 g0 = *(const float4*)(wg_s + i * 8), g1 = *(const float4*)(wg_s + i * 8 + 4);
        s += lo2f(q.x) * g0.x + hi2f(q.x) * g0.y + lo2f(q.y) * g0.z + hi2f(q.y) * g0.w + lo2f(q.z) * g1.x + hi2f(q.z) * g1.y + lo2f(q.w) * g1.z +
             hi2f(q.w) * g1.w;
      }
      nreg = decay * nreg + s;
      ns[tid] = nreg;
    }
    {
      const bf16_t* bp = VTs + (16 * wave + n16) * 72 + 8 * q4;
      const bf16x8 b0 = *(const bf16x8*)(bp), b1 = *(const bf16x8*)(bp + 32);
      const bf16_t* ap = KTs + n16 * 72 + 8 * q4;
#pragma unroll
      for (int kt = 0; kt < 16; ++kt) {
        cst[kt] *= decay;
        cst[kt] = MFMA16(*(const bf16x8*)(ap + kt * 16 * 72), b0, cst[kt]);
        cst[kt] = MFMA16(*(const bf16x8*)(ap + kt * 16 * 72 + 32), b1, cst[kt]);
        if ((kt & 3) == 3) __builtin_amdgcn_sched_barrier(0);
      }
    }
    if (j + 1 < 32) PUT_QK();
    mstate = m_new;
    __syncthreads();
  }
#undef PF_QK
#undef PF_TV
#undef PUT_QK
}

DI void attn_item(const Ctx& c, int item) {
  const int kvg = item & 1, hh = (item >> 1) & 1, qb = (item >> 2) & 15, seq = item >> 6;
  const int tid = c.tid, lane = tid & 63, wave = tid >> 6, r = lane & 31, h = lane >> 5;
  const bf16_t* proj = (const bf16_t*)(c.ws() + OFF_R1);
  bf16_t* ya = (bf16_t*)(c.ws() + OFF_R5);
  bf16_t* Kt = c.lds;
  bf16_t* VTt = Kt + 9216;
  const int head = kvg * 4 + hh * 2 + (wave >> 2), slice = wave & 3;
  const float L2E = 1.4426950408889634f;
  const float nslope2 = -exp2f(-(float)(head + 1)) * L2E, qscale2 = 0.125f * L2E;
  const float sink = c.in(I_SINK)[c.l * 8 + head] * L2E;
  const int q0 = qb * 128 + slice * 32;
  bf16x8 qf[4];
#pragma unroll
  for (int ks = 0; ks < 4; ++ks)
    qf[ks] = *(const bf16x8*)(proj + (size_t)(seq * SEQ + q0 + r) * LDP + P_AQ + head * 64 + ks * 16 + h * 8);
  f32x16 O[2];
#pragma unroll
  for (int e = 0; e < 16; ++e) { O[0][e] = 0.f; O[1][e] = 0.f; }
  float mrun = sink, lsum = 0.f;
  const int kb_lo = (qb == 0) ? 1 : 0, kb_hi = (qb == 15) ? 2 : 3;
  const int kkey = tid >> 3, kdc = (tid & 7) * 8, vkey = tid & 127, vdc = (tid >> 7) * 16;
  const bf16_t* kbase = proj + (size_t)(seq * SEQ + qb * 128 - 128) * LDP + P_AK + kvg * 64;
  const bf16_t* vbase = proj + (size_t)(seq * SEQ + qb * 128 - 128) * LDP + P_AV + kvg * 64;
  uint4 rk0, rk1, rv0, rv1;
  {
    const size_t o = (size_t)kb_lo * 128 * LDP;
    rk0 = *(const uint4*)(kbase + o + (size_t)kkey * LDP + kdc); rk1 = *(const uint4*)(kbase + o + (size_t)(kkey + 64) * LDP + kdc);
    rv0 = *(const uint4*)(vbase + o + (size_t)vkey * LDP + vdc); rv1 = *(const uint4*)(vbase + o + (size_t)vkey * LDP + vdc + 8);
  }
#pragma unroll 1
  for (int kb = kb_lo; kb < kb_hi; ++kb) {
    const int kstart = qb * 128 - 128 + kb * 128;
    *(uint4*)(Kt + kkey * 72 + kdc) = rk0; *(uint4*)(Kt + (kkey + 64) * 72 + kdc) = rk1;
    {
      bf16_t* vd = VTt + vdc * 136 + vkey;
      vd[0 * 136] = (bf16_t)(rv0.x & 0xffff); vd[1 * 136] = (bf16_t)(rv0.x >> 16); vd[2 * 136] = (bf16_t)(rv0.y & 0xffff); vd[3 * 136] = (bf16_t)(rv0.y >> 16);
      vd[4 * 136] = (bf16_t)(rv0.z & 0xffff); vd[5 * 136] = (bf16_t)(rv0.z >> 16); vd[6 * 136] = (bf16_t)(rv0.w & 0xffff); vd[7 * 136] = (bf16_t)(rv0.w >> 16);
      vd[8 * 136] = (bf16_t)(rv1.x & 0xffff); vd[9 * 136] = (bf16_t)(rv1.x >> 16); vd[10 * 136] = (bf16_t)(rv1.y & 0xffff); vd[11 * 136] = (bf16_t)(rv1.y >> 16);
      vd[12 * 136] = (bf16_t)(rv1.z & 0xffff); vd[13 * 136] = (bf16_t)(rv1.z >> 16); vd[14 * 136] = (bf16_t)(rv1.w & 0xffff); vd[15 * 136] = (bf16_t)(rv1.w >> 16);
    }
    __syncthreads();
    if (kb + 1 < kb_hi) {
      const size_t o = (size_t)(kb + 1) * 128 * LDP;
      rk0 = *(const uint4*)(kbase + o + (size_t)kkey * LDP + kdc); rk1 = *(const uint4*)(kbase + o + (size_t)(kkey + 64) * LDP + kdc);
      rv0 = *(const uint4*)(vbase + o + (size_t)vkey * LDP + vdc); rv1 = *(const uint4*)(vbase + o + (size_t)vkey * LDP + vdc + 8);
    }
    f32x16 s[4];
#pragma unroll
    for (int nt = 0; nt < 4; ++nt) {
#pragma unroll
      for (int e = 0; e < 16; ++e) s[nt][e] = 0.f;
#pragma unroll
      for (int ks = 0; ks < 4; ++ks) s[nt] = MFMA(*(const bf16x8*)(Kt + (nt * 32 + r) * 72 + ks * 16 + h * 8), qf[ks], s[nt]);
    }
    const float drel = (float)(kstart - (q0 + r) + 4 * h);
    float mx = -INFINITY;
    if (kstart == qb * 128) {
#pragma unroll
      for (int nt = 0; nt < 4; ++nt)
#pragma unroll
        for (int e = 0; e < 16; ++e) {
          const float d = drel + (float)(nt * 32 + (e & 3) + 8 * (e >> 2));
          const float v = fmaf(nslope2, fabsf(d), s[nt][e] * qscale2);
          s[nt][e] = v; mx = fmaxf(mx, v);
        }
    } else {
#pragma unroll
      for (int nt = 0; nt < 4; ++nt)
#pragma unroll
        for (int e = 0; e < 16; ++e) {
          const float d = drel + (float)(nt * 32 + (e & 3) + 8 * (e >> 2));
          const float v = (fabsf(d) <= 128.f) ? fmaf(nslope2, fabsf(d), s[nt][e] * qscale2) : -INFINITY;
          s[nt][e] = v; mx = fmaxf(mx, v);
        }
    }
    mx = fmaxf(mx, bperm(lane ^ 32, mx));
    const float mn = fmaxf(mrun, mx);
    const float alpha = __builtin_amdgcn_exp2f(mrun - mn);
    mrun = mn;
    float ls = 0.f;
#pragma unroll
    for (int nt = 0; nt < 4; ++nt)
#pragma unroll
      for (int e = 0; e < 16; ++e) { const float pv = __builtin_amdgcn_exp2f(s[nt][e] - mn); s[nt][e] = pv; ls += pv; }
    lsum = lsum * alpha + ls;
#pragma unroll
    for (int e = 0; e < 16; ++e) { O[0][e] *= alpha; O[1][e] *= alpha; }
#pragma unroll
    for (int nt = 0; nt < 4; ++nt)
#pragma unroll
      for (int s2 = 0; s2 < 2; ++s2) {
        uint4 pu;
        pu.x = pack2(s[nt][8 * s2], s[nt][8 * s2 + 1]); pu.y = pack2(s[nt][8 * s2 + 2], s[nt][8 * s2 + 3]);
        pu.z = pack2(s[nt][8 * s2 + 4], s[nt][8 * s2 + 5]); pu.w = pack2(s[nt][8 * s2 + 6], s[nt][8 * s2 + 7]);
        const bf16x8 pfrag = __builtin_bit_cast(bf16x8, pu);
        const bf16_t* vp = VTt + r * 136 + nt * 32 + 16 * s2 + 4 * h;
        O[0] = MFMA(frag_from(*(const uint2*)vp, *(const uint2*)(vp + 8)), pfrag, O[0]);
        O[1] = MFMA(frag_from(*(const uint2*)(vp + 32 * 136), *(const uint2*)(vp + 32 * 136 + 8)), pfrag, O[1]);
      }
    __syncthreads();
  }
  float l = lsum + bperm(lane ^ 32, lsum);
  l += __builtin_amdgcn_exp2f(sink - mrun);
  const float inv = 1.f / l;
  bf16_t* op = ya + (size_t)(seq * SEQ + q0 + r) * 1024 + head * 64 + 4 * h;
#pragma unroll
  for (int dt = 0; dt < 2; ++dt)
#pragma unroll
    for (int g = 0; g < 4; ++g) {
      uint2 o; o.x = pack2(O[dt][4 * g] * inv, O[dt][4 * g + 1] * inv); o.y = pack2(O[dt][4 * g + 2] * inv, O[dt][4 * g + 3] * inv);
      *(uint2*)(op + dt * 32 + 8 * g) = o;
    }
}

DI void sgu_item(const Ctx& c, int item) {
  const int chunk = item & 15, seq = item >> 4;
  const int tid = c.tid, lane = tid & 63, wave = tid >> 6, r = lane & 31, h = lane >> 5;
  const bf16_t* proj = (const bf16_t*)(c.ws() + OFF_R1);
  bf16_t* yc = (bf16_t*)(c.ws() + OFF_R5) + 512;
  bf16_t* wsb = c.lds;
  bf16_t* vnT = wsb + 128 * 136;
  float* mean_s = (float*)(vnT + 128 * 136); float* rstd_s = mean_s + 128;
  const int t0 = seq * SEQ + chunk * 128;
  const float* lnw = c.in(I_CLNW) + (size_t)c.l * 512;
  const float* lnb = c.in(I_CLNB) + (size_t)c.l * 512;
  {
    const int tok = tid >> 2, part = tid & 3;
    float s = 0.f, q = 0.f;
#pragma unroll
    for (int i = 0; i < 16; ++i) {
      const uint4 v = *(const uint4*)(proj + (size_t)(t0 + tok) * LDP + P_V + part * 128 + i * 8);
      const float f[8] = {lo2f(v.x), hi2f(v.x), lo2f(v.y), hi2f(v.y), lo2f(v.z), hi2f(v.z), lo2f(v.w), hi2f(v.w)};
#pragma unroll
      for (int jj = 0; jj < 8; ++jj) { s += f[jj]; q += f[jj] * f[jj]; }
    }
    s += sx<1>(s); s += sx<2>(s); q += sx<1>(q); q += sx<2>(q);
    const float mean = s * (1.f / 512.f);
    const float var = fmaxf(q * (1.f / 512.f) - mean * mean, 0.f);
    if (part == 0) { mean_s[tok] = mean; rstd_s[tok] = rsqrtf(var + LN_EPS); }
  }
  __syncthreads();
  const int ct = wave >> 1, tt0 = (wave & 1) * 2;
  const int ws_t = tid >> 5, ws_q = (tid & 31) * 4;
  const int vs_s = tid & 127, vs_c = (tid >> 7) * 8;
  float4 rw[8]; uint4 rv[4];
#define SGU_PREFETCH(g_) do { const float* wsg_ = c.in(I_CWS) + ((size_t)(c.l * 4 + (g_))) * 16384; \
    _Pragma("unroll") for (int i = 0; i < 8; ++i) rw[i] = *(const float4*)(wsg_ + (ws_t + 16 * i) * 128 + ws_q); \
    _Pragma("unroll") for (int i = 0; i < 4; ++i) rv[i] = *(const uint4*)(proj + (size_t)(t0 + vs_s) * LDP + P_V + (g_) * 128 + vs_c + 32 * i); } while (0)
  SGU_PREFETCH(0);
#pragma unroll 1
  for (int gq = 0; gq < 4; ++gq) {
#pragma unroll
    for (int i = 0; i < 8; ++i) { uint2 o; o.x = pack2(rw[i].x, rw[i].y); o.y = pack2(rw[i].z, rw[i].w); *(uint2*)(wsb + (ws_t + 16 * i) * 136 + ws_q) = o; }
    {
      const float mean = mean_s[vs_s], rstd = rstd_s[vs_s];
#pragma unroll
      for (int i = 0; i < 4; ++i) {
        const int cc = vs_c + 32 * i;
        const uint4 v = rv[i];
        const float4 w0 = *(const float4*)(lnw + gq * 128 + cc), w1 = *(const float4*)(lnw + gq * 128 + cc + 4);
        const float4 b0 = *(const float4*)(lnb + gq * 128 + cc), b1 = *(const float4*)(lnb + gq * 128 + cc + 4);
        bf16_t* d = vnT + cc * 136 + vs_s;
        d[0 * 136] = f2bf((lo2f(v.x) - mean) * rstd * w0.x + b0.x); d[1 * 136] = f2bf((hi2f(v.x) - mean) * rstd * w0.y + b0.y);
        d[2 * 136] = f2bf((lo2f(v.y) - mean) * rstd * w0.z + b0.z); d[3 * 136] = f2bf((hi2f(v.y) - mean) * rstd * w0.w + b0.w);
        d[4 * 136] = f2bf((lo2f(v.z) - mean) * rstd * w1.x + b1.x); d[5 * 136] = f2bf((hi2f(v.z) - mean) * rstd * w1.y + b1.y);
        d[6 * 136] = f2bf((lo2f(v.w) - mean) * rstd * w1.z + b1.z); d[7 * 136] = f2bf((hi2f(v.w) - mean) * rstd * w1.w + b1.w);
      }
    }
    __syncthreads();
    if (gq < 3) SGU_PREFETCH(gq + 1);
    uint2 u[2][4];
    const float* bs = c.in(I_CBS) + ((size_t)(c.l * 4 + gq)) * 128;
    float bb[2];
#pragma unroll
    for (int i = 0; i < 2; ++i) {
      const int t = (tt0 + i) * 32 + r;
      bb[i] = bs[t];
      const bf16_t* up = proj + (size_t)(t0 + t) * LDP + P_U + gq * 128 + ct * 32 + 4 * h;
#pragma unroll
      for (int g = 0; g < 4; ++g) u[i][g] = *(const uint2*)(up + 8 * g);
    }
    f32x16 acc[2];
#pragma unroll
    for (int e = 0; e < 16; ++e) { acc[0][e] = 0.f; acc[1][e] = 0.f; }
#pragma unroll
    for (int ks = 0; ks < 8; ++ks) {
      const bf16x8 a = *(const bf16x8*)(vnT + (ct * 32 + r) * 136 + ks * 16 + h * 8);
      acc[0] = MFMA(a, *(const bf16x8*)(wsb + (tt0 * 32 + r) * 136 + ks * 16 + h * 8), acc[0]);
      acc[1] = MFMA(a, *(const bf16x8*)(wsb + (tt0 * 32 + 32 + r) * 136 + ks * 16 + h * 8), acc[1]);
    }
#pragma unroll
    for (int i = 0; i < 2; ++i) {
      const int t = (tt0 + i) * 32 + r;
      bf16_t* op = yc + (size_t)(t0 + t) * 1024 + gq * 128 + ct * 32 + 4 * h;
#pragma unroll
      for (int g = 0; g < 4; ++g) {
        uint2 o;
        o.x = pack2(lo2f(u[i][g].x) * (acc[i][4 * g] + bb[i]), hi2f(u[i][g].x) * (acc[i][4 * g + 1] + bb[i]));
        o.y = pack2(lo2f(u[i][g].y) * (acc[i][4 * g + 2] + bb[i]), hi2f(u[i][g].y) * (acc[i][4 * g + 3] + bb[i]));
        *(uint2*)(op + 8 * g) = o;
      }
    }
    __syncthreads();
  }
#undef SGU_PREFETCH
}

DI void phase_mix(const Ctx& c) {
  constexpr int N_SCAN = GSEQ * 16, N_ATT = GSEQ * 64, N_SGU = GSEQ * 16;
  for (int it = c.bid; it < N_SCAN + N_ATT + N_SGU; it += c.nb) {
    Ctx c2 = c;
    asm volatile("" : "+v"(c2.tid));
    asm volatile("" : "+s"(c2.wsp));
    if (it < N_SCAN) {
      const int sa = it >> 3, sx = it & 7;
      scan_item(c2, ((sx + 8 * (sa >> 1)) << 1) | (sa & 1));
#if REPEAT_SCAN
      __syncthreads(); asm volatile("" : "+v"(c2.tid)); scan_item(c2, ((sx + 8 * (sa >> 1)) << 1) | (sa & 1));
#endif
    }
    else if (it < N_SCAN + N_ATT) { attn_item(c2, it - N_SCAN);
#if REPEAT_ATT
      __syncthreads(); asm volatile("" : "+v"(c2.tid)); attn_item(c2, it - N_SCAN);
#endif
    }
    else sgu_item(c2, it - N_SCAN - N_ATT);
    __syncthreads();
  }
}

#define XB_TMO      128
#define XB_XCNT(j)  (256  + 64 * (j))
#define XB_XSUB(j)  (1280 + 64 * (j))
#define XB_XGEN(j)  (2304 + 64 * (j))
#define XB_TOP      3328
#define XB_TOPGEN   3392
#define XCD_BAR_WORDS 3456
#define XB_SPIN_CAP (1u << 18)
DI unsigned xb_ld(unsigned* p) { return __hip_atomic_load(p, __ATOMIC_RELAXED, __HIP_MEMORY_SCOPE_AGENT); }
DI unsigned xb_add(unsigned* p, unsigned v) { return __hip_atomic_fetch_add(p, v, __ATOMIC_RELAXED, __HIP_MEMORY_SCOPE_AGENT); }
DI unsigned xb_xcc_id() { return (unsigned)__builtin_amdgcn_s_getreg((3 << 11) | 20) & 0xFu; }
#define XB_SPIN(cond, bar) do { unsigned _sp = 0; while (cond) { __builtin_amdgcn_s_sleep(1); \
    if ((++_sp & 255u) == 0u) { if (xb_ld(&(bar)[XB_TMO])) break; if (_sp > XB_SPIN_CAP) { atomicAdd(&(bar)[XB_TMO], 1u); break; } } } } while (0)
struct XcdBarrier { unsigned* bar; unsigned x; volatile LAS unsigned* st; };
DI XcdBarrier xcd_barrier_post(unsigned* bar, volatile LAS unsigned* st) {
  XcdBarrier b; b.bar = bar; b.x = xb_xcc_id(); b.st = st;
  if (threadIdx.x == 0) (void)xb_add(&bar[XB_XCNT(b.x)], 1u);
  return b;
}
DI void xcd_barrier_complete(unsigned* bar, unsigned x, unsigned& nloc, unsigned& nx) {
  const unsigned G = gridDim.x * gridDim.y * gridDim.z;
  unsigned sum, cnt, mine, sp = 0u;
  for (;;) {
    sum = 0u; cnt = 0u; mine = 0u;
#pragma unroll
    for (unsigned j = 0; j < 16; ++j) { const unsigned c = xb_ld(&bar[XB_XCNT(j)]); sum += c; cnt += (c > 0u) ? 1u : 0u; mine = (j == x) ? c : mine; }
    if (sum == G) break;
    __builtin_amdgcn_s_sleep(1);
    if ((++sp & 255u) == 0u) { if (xb_ld(&bar[XB_TMO])) break; if (sp > XB_SPIN_CAP) { atomicAdd(&bar[XB_TMO], 1u); break; } }
  }
  nloc = mine > 0u ? mine : 1u; nx = cnt > 0u ? cnt : 1u;
}
DI void xcd_barrier(const XcdBarrier& b) {
  asm volatile("s_waitcnt vmcnt(0)" ::: "memory");
  __syncthreads();
  if (threadIdx.x == 0) {
    unsigned* bar = b.bar;
    __builtin_amdgcn_s_waitcnt(0);
    unsigned nloc = b.st[0], nx = b.st[1];
    if (nloc == 0u) { xcd_barrier_complete(bar, b.x, nloc, nx); b.st[0] = nloc; b.st[1] = nx; }
    const unsigned old = xb_add(&bar[XB_XSUB(b.x)], 1u);
    const unsigned gen = old / nloc;
    if (old + 1u == (gen + 1u) * nloc) {
      __builtin_amdgcn_fence(__ATOMIC_RELEASE, "agent");
      asm volatile("s_waitcnt vmcnt(0)" ::: "memory");
      const unsigned og = xb_add(&bar[XB_TOP], 1u);
      const unsigned tg = og / nx;
      if (og + 1u == (tg + 1u) * nx) xb_add(&bar[XB_TOPGEN], 1u);
      else XB_SPIN(xb_ld(&bar[XB_TOPGEN]) == tg, bar);
      __builtin_amdgcn_fence(__ATOMIC_ACQUIRE, "agent");
      xb_add(&bar[XB_XGEN(b.x)], 1u);
      asm volatile("s_waitcnt vmcnt(0)" ::: "memory");
    } else {
      XB_SPIN(xb_ld(&bar[XB_XGEN(b.x)]) == gen, bar);
      __builtin_amdgcn_fence(__ATOMIC_ACQUIRE, "agent");
      asm volatile("s_waitcnt vmcnt(0)" ::: "memory");
    }
  }
  __syncthreads();
}

constexpr int STEPS_PER_LAYER = 11, STEPS_PER_GROUP = 1 + DEPTH * STEPS_PER_LAYER, N_STEPS = 1 + NGROUP * STEPS_PER_GROUP;

DI void run_step(const Params& P, int step, bf16_t* lds) {
  int tid = threadIdx.x, bid = blockIdx.x, nb = gridDim.x;
  unsigned char* wsp = P.ws;
  asm volatile("" : "+v"(tid));
  asm volatile("" : "+s"(bid), "+s"(nb), "+s"(wsp));
  if (step == 0) {
    for (int it = bid; it < PREP_ITEMS; it += nb) prep_item(P, it, lds, tid);
    return;
  }
  step -= 1;
  Ctx c; c.p = &P; c.lds = lds; c.tid = tid; c.bid = bid; c.nb = nb; c.wsp = wsp;
  c.g = step / STEPS_PER_GROUP; int s = step - c.g * STEPS_PER_GROUP;
  if (s == 0) { c.l = 0; phase_xm0(c); return; }
  s -= 1; c.l = s / STEPS_PER_LAYER; s -= c.l * STEPS_PER_LAYER;
  const int l = c.l;
  switch (s) {
    case 0: phase_g1(c); break;
    case 1: phase_conv(c); gate_prepass(c); break;
    case 2: phase_g2(c); break;
    case 3: phase_mix(c); break;
    case 4: phase_post(c); break;
    case 5: phase_merge(c); break;
    case 6: phase_wout(c); break;
    case 7: phase_ln(c, (const bf16_t*)(wsp + OFF_R3 + 64 * MiB), c.xin(), c.in(I_LN1W) + l * 1024, c.in(I_LN1B) + l * 1024, l, 3, 4); break;
    case 8: phase_mlp1(c); break;
    case 9: phase_mlp2(c); break;
    case 10: phase_ln(c, (const bf16_t*)(wsp + OFF_R1 + 256 * MiB), c.xout(), c.in(I_LN2W) + l * 1024, c.in(I_LN2B) + l * 1024, (l + 1 < DEPTH) ? l + 1 : -1, 0, 1); break;
  }
}

__global__ void __launch_bounds__(NT) fwd_megakernel(Params P) {
  extern __shared__ __attribute__((aligned(16))) unsigned char smem[];
  bf16_t* lds = (bf16_t*)smem;
  cg::grid_group grid = cg::this_grid();
  volatile LAS unsigned* xst = (volatile LAS unsigned*)(LAS unsigned char*)(smem + LDS_WORK);
  if (threadIdx.x < 4) xst[threadIdx.x] = 0u;
  __syncthreads();
  const XcdBarrier xb = xcd_barrier_post((unsigned*)(P.ws + OFF_BAR), xst);
  for (int s = P.step_lo; s < P.step_hi; ++s) {
    run_step(P, s, lds);
#if REPEAT_MASK
    {
      int rs = -1;
      if (s == 0) rs = 12; else { int q = (s - 1) % STEPS_PER_GROUP; rs = (q == 0) ? 11 : (q - 1) % STEPS_PER_LAYER; }
      if ((REPEAT_MASK >> rs) & 1) { grid.sync(); run_step(P, s, lds); }
    }
#endif
#if EXTRA_SYNC
    grid.sync();
#endif
    if (s + 1 < P.step_hi) { if (s == 0) grid.sync(); else xcd_barrier(xb); }
  }
}

extern "C" void kernel_launch(void* const* d_in, const int* in_sizes, int n_in, void* d_out, int out_size, void* d_ws, size_t ws_size,
                              hipStream_t stream) {
  static int grid_blocks = 0;
  if (!grid_blocks) {
    int dev = 0, cus = 0, per_cu = 0;
    hipGetDevice(&dev);
    hipDeviceGetAttribute(&cus, hipDeviceAttributeMultiprocessorCount, dev);
    hipFuncSetAttribute((const void*)fwd_megakernel, hipFuncAttributeMaxDynamicSharedMemorySize, LDS_BYTES);
    hipOccupancyMaxActiveBlocksPerMultiprocessor(&per_cu, (const void*)fwd_megakernel, NT, LDS_BYTES);
    if (per_cu < 1) per_cu = 1;
    grid_blocks = cus * per_cu;
    if (ws_size < WS_END) fprintf(stderr, "workspace too small: %zu < %zu\n", ws_size, (size_t)WS_END);
  }
  Params p{};
  for (int i = 0; i < 31; ++i) p.in[i] = (const float*)d_in[i];
  p.out = (float*)d_out; p.ws = (unsigned char*)d_ws;
#if MULTI_LAUNCH
  for (int s = 0; s < N_STEPS; ++s) {
    p.step_lo = s; p.step_hi = s + 1;
    hipLaunchKernelGGL(fwd_megakernel, dim3(grid_blocks), dim3(NT), LDS_BYTES, stream, p);
  }
#else
  p.step_lo = 0; p.step_hi = N_STEPS;
  (void)hipMemsetAsync((char*)d_ws + OFF_BAR, 0, XCD_BAR_WORDS * sizeof(unsigned), stream);
  void* args[] = {&p};
  hipError_t e = hipLaunchCooperativeKernel((const void*)fwd_megakernel, dim3(grid_blocks), dim3(NT), args, LDS_BYTES, stream);
  if (e != hipSuccess) fprintf(stderr, "cooperative launch failed: %s (grid %d)\n", hipGetErrorString(e), grid_blocks);
#endif
}
```

```cpp
#include <hip/hip_runtime.h>
#include <hip/hip_cooperative_groups.h>
#include <cstdio>
namespace cg = cooperative_groups;

typedef unsigned short bf16_t;
using bf16x8 = __attribute__((ext_vector_type(8))) short;
using f32x16 = __attribute__((ext_vector_type(16))) float;
#define DI __device__ __forceinline__
#define MFMA(a, b, c) __builtin_amdgcn_mfma_f32_32x32x16_bf16((a), (b), (c), 0, 0, 0)

#ifndef MULTI_LAUNCH
#define MULTI_LAUNCH 0
#endif
#ifndef REPEAT_MASK
#define REPEAT_MASK 0
#ifndef REPEAT_ATT
#define REPEAT_ATT 0
#endif
#ifndef REPEAT_SCAN
#define REPEAT_SCAN 0
#endif
#endif
#ifndef PROBE_EPI2
#define PROBE_EPI2 0
#endif
#ifndef EXTRA_SYNC
#define EXTRA_SYNC 0
#endif

constexpr int NT = 512;
constexpr int SEQ = 2048, D = 1024;
constexpr int GSEQ = 16;
constexpr int TG = GSEQ * SEQ;
constexpr int NGROUP = 3;
constexpr int NSEQ_ALL = 48;
constexpr int DEPTH = 2;
constexpr int N_IN = 6928, N_INP = 7168;
constexpr int LDP = 6912;
constexpr int P_XM = 0, P_Z = 1024, P_AQ = 2048, P_AK = 2560, P_AV = 2688, P_U = 2816, P_V = 3328, P_G = 3840;
constexpr float ALPHA = 1.4142135623730951f;
constexpr float LN_EPS = 1e-5f;

enum { I_XP = 0, I_XS, I_CP, I_CS, I_ADAW, I_ADAB, I_WIN, I_BIN, I_CONVW, I_CONVB, I_WQ, I_WK, I_WV, I_NORMW, I_SINK,
       I_CLNW, I_CLNB, I_CWS, I_CBS, I_PM, I_PA, I_PC, I_WOUT, I_LN1W, I_LN1B, I_W1, I_B1, I_W2, I_B2, I_LN2W, I_LN2B };

constexpr size_t W_IN = 0, W_QKV = 7340032, W_PM = 8126464, W_PA = 9175040  , W_PC = W_PA + 512, W_OUT = 10223616,
                 W_1 = 11272192, W_2 = 15466496, W_LAYER = 19660800;
constexpr size_t MiB = 1u << 20;
constexpr size_t OFF_W = 0;
constexpr size_t OFF_MOD = 80 * MiB;
constexpr size_t OFF_BINP = 83 * MiB;
constexpr size_t OFF_R0 = 84 * MiB;
constexpr size_t OFF_R2 = 148 * MiB;
constexpr size_t OFF_R1 = 212 * MiB;
constexpr size_t OFF_R3 = 644 * MiB;
constexpr size_t OFF_R5 = 900 * MiB;
constexpr size_t OFF_GATES = 964 * MiB;
constexpr size_t OFF_GPRE = 966 * MiB;
constexpr size_t OFF_BAR = 970 * MiB;
constexpr size_t WS_END = 971 * MiB;

constexpr int LDS_WORK = 150 * 1024;
constexpr int LDS_BYTES = LDS_WORK + 64;

struct Params {
  const float* in[31];
  float* out;
  unsigned char* ws;
  int step_lo, step_hi;
};

typedef __bf16 bf2_t __attribute__((ext_vector_type(2)));
typedef float f2_t __attribute__((ext_vector_type(2)));
DI bf16_t f2bf(float x) { return __builtin_bit_cast(unsigned short, (__bf16)x); }
DI float bf2f(bf16_t b) { return __uint_as_float(((unsigned)b) << 16); }
DI unsigned pack2(float a, float b) { f2_t v = {a, b}; return __builtin_bit_cast(unsigned, __builtin_convertvector(v, bf2_t)); }
DI float lo2f(unsigned u) { return __uint_as_float(u << 16); }
DI float hi2f(unsigned u) { return __uint_as_float(u & 0xffff0000u); }
DI int crow(int e, int h) { return (e & 3) + 8 * (e >> 2) + 4 * h; }
DI float sigmoidf_(float x) { return __builtin_amdgcn_rcpf(1.f + __builtin_amdgcn_exp2f(-1.4426950408889634f * x)); }
DI float gelu_tanh(float x) {
  const float u2 = 1.5957691216057308f * (x + 0.044715f * x * x * x);
  return x * __builtin_amdgcn_rcpf(1.f + __builtin_amdgcn_exp2f(-1.4426950408889634f * u2));
}
template <int M> DI float sx(float v) { return __int_as_float(__builtin_amdgcn_ds_swizzle(__float_as_int(v), (M << 10) | 0x1F)); }
DI float bperm(int src_lane, float v) { return __int_as_float(__builtin_amdgcn_ds_bpermute(src_lane << 2, __float_as_int(v))); }
DI float wsum(float v, int lane) { v += sx<1>(v); v += sx<2>(v); v += sx<4>(v); v += sx<8>(v); v += sx<16>(v); v += bperm(lane ^ 32, v); return v; }

#define LAS __attribute__((address_space(3)))
using f32x4 = __attribute__((ext_vector_type(4))) float;
constexpr int GBK = 64, GHALF = 128, HTB = GHALF * GBK * 2;
DI int lds_byte(int r, int c) { const int st = (r >> 4) * 2 + (c >> 5), rr = r & 15, cc = c & 31, ob = rr * 64 + cc * 2; return st * 1024 + (ob ^ (((ob >> 9) & 1) << 5)); }
DI void stage_rc(int b, int& R, int& C) { const int st = b / 1024, sb = b % 1024, swz = sb ^ (((sb >> 9) & 1) << 5); R = (st >> 1) * 16 + swz / 64; C = (st & 1) * 32 + (swz % 64) / 2; }
DI int perm32(int rho) { const int n = rho >> 4, i = rho & 15; return 8 * (i >> 2) + 4 * n + (i & 3); }
struct GUnit { const char* A; const char* B; int nt, pm, pn, tag; };
typedef f32x4 GAcc[2][2][4][2];

DI void static_unit(int L, int nM, int nN, int& pm, int& pn) {
  const int nwg = nM * nN;
  int wgid = L; { const int q = nwg / 8, r = nwg % 8, xcd = wgid % 8, off = wgid / 8; wgid = (xcd < r ? xcd * (q + 1) : r * (q + 1) + (xcd - r) * q) + off; }
  const int nig = 8 * nN, gid = wgid / nig, fm = gid * 8, gsz = (nM - fm) < 8 ? (nM - fm) : 8;
  pm = fm + ((wgid % nig) % gsz); pn = (wgid % nig) / gsz;
}

template <class Sched, class Epi>
DI void gemm_phase8(bf16_t* lds_generic, int lda, int ldb, const Sched& S, const Epi& E, int tid) {
  LAS unsigned char* lds = (LAS unsigned char*)lds_generic;
  const int wid = __builtin_amdgcn_readfirstlane(tid >> 6), lane = tid & 63, wr = wid >> 2, wc = wid & 3, fr = lane & 15, fq = lane >> 4;
  unsigned voffA[2], voffB[2];
#pragma unroll
  for (int i = 0; i < 2; ++i) { int R, C; stage_rc(tid * 16 + i * 8192, R, C); const int Rb = (R & ~31) + perm32(R & 31);
    voffA[i] = (unsigned)(R * lda + C) * 2u; voffB[i] = (unsigned)(Rb * ldb + C) * 2u; }
  const size_t kstep = (size_t)(GBK * 2);
  const size_t hstepA = (size_t)GHALF * lda * 2, hstepB = (size_t)GHALF * ldb * 2;
  const unsigned ldsw = (unsigned)wid * 1024u;
  const int aoff = lds_byte(wr * 64 + fr, fq * 8), boff = lds_byte(wc * 32 + fr, fq * 8);
#define PG8_SA(b, h) (((b) * 2 + (h)) * HTB)
#define PG8_SB(b, h) ((4 + (b) * 2 + (h)) * HTB)
#define PG8_STAGE(bufoff, gbase, voff) do { _Pragma("unroll") for (int _i = 0; _i < 2; ++_i) \
    __builtin_amdgcn_global_load_lds((const unsigned*)((const char*)(gbase) + (voff)[_i]), (LAS unsigned*)(lds + (bufoff) + ldsw + _i * 8192), 16, 0, 0); } while (0)
#define PG8_LDA(dst, b, h) do { _Pragma("unroll") for (int m = 0; m < 4; ++m) _Pragma("unroll") for (int k = 0; k < 2; ++k) dst[m][k] = *(const LAS bf16x8*)(lds + PG8_SA(b, h) + aoff + m * 2048 + k * 1024); } while (0)
#define PG8_LDB(dst, b, h) do { _Pragma("unroll") for (int n = 0; n < 2; ++n) _Pragma("unroll") for (int k = 0; k < 2; ++k) dst[n][k] = *(const LAS bf16x8*)(lds + PG8_SB(b, h) + boff + n * 2048 + k * 1024); } while (0)
#define PG8_MMA(ai, bj, At, Bt) do { __builtin_amdgcn_s_setprio(1); _Pragma("unroll") for (int m = 0; m < 4; ++m) _Pragma("unroll") for (int n = 0; n < 2; ++n) _Pragma("unroll") for (int k = 0; k < 2; ++k) \
    acc[ai][bj][m][n] = __builtin_amdgcn_mfma_f32_16x16x32_bf16(Bt[n][k], At[m][k], acc[ai][bj][m][n], 0, 0, 0); __builtin_amdgcn_s_setprio(0); } while (0)
#define PG8_WAIT_V(n) asm volatile("s_waitcnt vmcnt(" #n ")" ::: "memory")
#define PG8_WAIT_L(n) asm volatile("s_waitcnt lgkmcnt(" #n ")" ::: "memory")
#define PG8_BAR __builtin_amdgcn_s_barrier()
#define PG8_SCHED __builtin_amdgcn_sched_barrier(0)
  GUnit cur, nxt; int ui = 0;
  if (!S(0, cur)) return;
  GAcc acc;
#pragma unroll
  for (int a = 0; a < 2; ++a)
#pragma unroll
    for (int b = 0; b < 2; ++b)
#pragma unroll
      for (int m = 0; m < 4; ++m)
#pragma unroll
        for (int n = 0; n < 2; ++n) acc[a][b][m][n] = (f32x4){0.f, 0.f, 0.f, 0.f};
  bf16x8 At[4][2], B0[2][2], B1[2][2];
  const char* cA = cur.A; const char* cB = cur.B;
  PG8_STAGE(PG8_SB(0, 0), cB, voffB); PG8_STAGE(PG8_SA(0, 0), cA, voffA); PG8_STAGE(PG8_SB(0, 1), cB + hstepB, voffB); PG8_STAGE(PG8_SA(0, 1), cA + hstepA, voffA);
  if (wr == 1) PG8_BAR;
  PG8_WAIT_V(4); PG8_BAR;
  PG8_STAGE(PG8_SB(1, 0), cB + kstep, voffB); PG8_STAGE(PG8_SA(1, 0), cA + kstep, voffA); PG8_STAGE(PG8_SB(1, 1), cB + hstepB + kstep, voffB);
  PG8_WAIT_V(6); PG8_BAR;
  for (;;) {
    const bool has_next = S(ui + 1, nxt);
    const char* nA = has_next ? nxt.A : cA; const char* nB = has_next ? nxt.B : cB;
    const int nt = cur.nt;
#pragma unroll 1
    for (int t = 0; t < nt; t += 2) {
      const bool last = (t == nt - 2);
      const char* a1 = cA + (size_t)(t + 1) * kstep;
      const char* a2 = last ? nA : cA + (size_t)(t + 2) * kstep; const char* b2 = last ? nB : cB + (size_t)(t + 2) * kstep;
      const char* a3 = a2 + kstep; const char* b3 = b2 + kstep;
      PG8_LDB(B0, 0, 0); PG8_SCHED; PG8_LDA(At, 0, 0); PG8_STAGE(PG8_SA(1, 1), a1 + hstepA, voffA);
      PG8_WAIT_L(8); PG8_BAR; PG8_WAIT_L(0); PG8_MMA(0, 0, At, B0); PG8_BAR; PG8_SCHED;
      PG8_LDB(B1, 0, 1); PG8_STAGE(PG8_SB(0, 0), b2, voffB);
      PG8_BAR; PG8_WAIT_L(0); PG8_MMA(0, 1, At, B1); PG8_BAR;
      PG8_LDA(At, 0, 1); PG8_STAGE(PG8_SA(0, 0), a2, voffA);
      PG8_BAR; PG8_WAIT_L(0); PG8_MMA(1, 0, At, B0); PG8_BAR; PG8_SCHED;
      PG8_STAGE(PG8_SB(0, 1), b2 + hstepB, voffB);
      PG8_WAIT_V(6); PG8_BAR; PG8_MMA(1, 1, At, B1); PG8_BAR;
      PG8_LDB(B0, 1, 0); PG8_SCHED; PG8_LDA(At, 1, 0); PG8_STAGE(PG8_SA(0, 1), a2 + hstepA, voffA);
      PG8_WAIT_L(8); PG8_BAR; PG8_WAIT_L(0); PG8_MMA(0, 0, At, B0); PG8_BAR; PG8_SCHED;
      PG8_LDB(B1, 1, 1); PG8_STAGE(PG8_SB(1, 0), b3, voffB);
      PG8_BAR; PG8_WAIT_L(0); PG8_MMA(0, 1, At, B1); PG8_BAR;
      PG8_LDA(At, 1, 1); PG8_STAGE(PG8_SA(1, 0), a3, voffA);
      PG8_BAR; PG8_WAIT_L(0); PG8_MMA(1, 0, At, B0); PG8_BAR; PG8_SCHED;
      PG8_STAGE(PG8_SB(1, 1), b3 + hstepB, voffB);
      PG8_WAIT_V(6); PG8_BAR; PG8_MMA(1, 1, At, B1); PG8_BAR;
    }
    const bool keep = E(acc, cur, wr, wc, fr, fq);
#if PROBE_EPI2
    if (!keep) E(acc, cur, wr, wc, fr, fq);
#endif
    if (!has_next) break;
    if (!keep)
#pragma unroll
    for (int a = 0; a < 2; ++a)
#pragma unroll
      for (int b = 0; b < 2; ++b)
#pragma unroll
        for (int m = 0; m < 4; ++m)
#pragma unroll
          for (int n = 0; n < 2; ++n) acc[a][b][m][n] = (f32x4){0.f, 0.f, 0.f, 0.f};
    cur = nxt; cA = nA; cB = nB; ++ui;
  }
  PG8_WAIT_V(0);
  if (wr == 0) PG8_BAR;
  PG8_BAR;
#undef PG8_SA
#undef PG8_SB
#undef PG8_STAGE
#undef PG8_LDA
#undef PG8_LDB
#undef PG8_MMA
#undef PG8_WAIT_V
#undef PG8_WAIT_L
#undef PG8_BAR
#undef PG8_SCHED
}

template <class F> DI void for_rows8(const GAcc& acc, int wr, int wc, int fr, int fq, F f) {
#pragma unroll
  for (int ai = 0; ai < 2; ++ai)
#pragma unroll
    for (int m = 0; m < 4; ++m)
#pragma unroll
      for (int bj = 0; bj < 2; ++bj) f(ai * 128 + wr * 64 + m * 16 + fr, bj * 128 + wc * 32 + 8 * fq, acc[ai][bj][m][0], acc[ai][bj][m][1]);
}
template <class F> DI void for_rows8b(const GAcc& acc, int wr, int wc, int fr, int fq, F f) {
#pragma unroll
  for (int ai = 0; ai < 2; ++ai)
#pragma unroll
    for (int m = 0; m < 4; ++m)
#pragma unroll
      for (int bj = 0; bj < 2; ++bj) f(ai * 128 + wr * 64 + m * 16 + fr, bj * 128 + wc * 32 + 8 * fq, bj, acc[ai][bj][m][0], acc[ai][bj][m][1]);
}
struct ColVec { f32x4 v[2][2]; };
DI ColVec load_cols(const float* p, int wc, int fq) {
  ColVec c;
#pragma unroll
  for (int bj = 0; bj < 2; ++bj)
#pragma unroll
    for (int n = 0; n < 2; ++n) c.v[bj][n] = *(const f32x4*)(p + bj * 128 + wc * 32 + 8 * fq + 4 * n);
  return c;
}
DI uint4 pack8(f32x4 a, f32x4 b) { uint4 o; o.x = pack2(a[0], a[1]); o.y = pack2(a[2], a[3]); o.z = pack2(b[0], b[1]); o.w = pack2(b[2], b[3]); return o; }

struct Ctx {
  const Params* p;
  int g, l;
  int tid, bid, nb;
  unsigned char* wsp;
  bf16_t* lds;
  DI const float* in(int i) const { int ii = i; asm volatile("" : "+s"(ii)); return p->in[ii]; }
  DI unsigned char* ws() const { return wsp; }
  DI const bf16_t* W(size_t off) const { return (const bf16_t*)(wsp + OFF_W) + (size_t)l * W_LAYER + off; }
  DI const float* mod(int which, int seq_local) const {
    return (const float*)(wsp + OFF_MOD) + ((size_t)(l * NSEQ_ALL + g * GSEQ + seq_local)) * 6144 + which * 1024;
  }
  DI const float* xin() const {
    if (l == 0) return (g < 2) ? in(I_XP) + (size_t)g * TG * D : in(I_XS);
    return p->out + (size_t)g * TG * D;
  }
  DI float* xout() const { return p->out + (size_t)g * TG * D; }
};

DI void transpose_tile(const float* __restrict__ src, int ldsrc, int k0, int srccol0, int nvalid, bf16_t* __restrict__ dst, int lddst,
                       int n0, float scale, float* lds, int tid) {
  {
    const int n = tid & 63, kk = tid >> 6;
#pragma unroll
    for (int i = 0; i < 8; ++i) {
      const int k = kk + 8 * i;
      lds[k * 65 + n] = (n < nvalid) ? src[(size_t)(k0 + k) * ldsrc + srccol0 + n] : 0.f;
    }
  }
  __syncthreads();
  {
    const int k = tid & 63, nn = tid >> 6;
#pragma unroll
    for (int i = 0; i < 8; ++i) {
      const int n = nn + 8 * i;
      dst[(size_t)(n0 + n) * lddst + k0 + k] = f2bf(lds[k * 65 + n] * scale);
    }
  }
  __syncthreads();
}

DI void prep_item(const Params& P, int item, bf16_t* ldsb, int tid) {
  float* lds = (float*)ldsb;
  constexpr int PER_LAYER = 4800;
  if (item < 2 * PER_LAYER) {
    const int l = item / PER_LAYER; int it = item - l * PER_LAYER;
    bf16_t* wb = (bf16_t*)(P.ws + OFF_W) + (size_t)l * W_LAYER;
    if (it < 1792) {
      const int ntile = it >> 4, kt = it & 15;
      const int n0 = ntile * 64;
      int srccol0, nvalid;
      if (n0 < 2048) { srccol0 = n0; nvalid = 64; }
      else if (n0 < 6912) { srccol0 = n0 + 16; nvalid = 64; }
      else if (n0 == 6912) { srccol0 = 2048; nvalid = 16; }
      else { srccol0 = 0; nvalid = 0; }
      transpose_tile(P.in[I_WIN] + (size_t)l * 1024 * N_IN, N_IN, kt * 64, srccol0, nvalid, wb + W_IN, 1024, n0, 1.f, lds, tid);
      return;
    }
    it -= 1792;
    if (it < 192) {
      const int mh = it >> 4, tt = it & 15;
      const int which = mh >> 2, head = mh & 3;
      const float* src = P.in[I_WQ + which] + ((size_t)(l * 4 + head)) * 65536;
      transpose_tile(src, 256, (tt & 3) * 64, (tt >> 2) * 64, 64, wb + W_QKV + (size_t)mh * 65536, 256, (tt >> 2) * 64,
                     which == 1 ? 0.0625f : 1.f, lds, tid);
      return;
    }
    it -= 192;
    if (it < 256) { transpose_tile(P.in[I_PM] + (size_t)l * 1024 * 1024, 1024, (it & 15) * 64, (it >> 4) * 64, 64, wb + W_PM, 1024, (it >> 4) * 64, 1.f, lds, tid); return; }
    it -= 256;
    if (it < 128) { transpose_tile(P.in[I_PA] + (size_t)l * 512 * 1024, 1024, (it & 7) * 64, (it >> 3) * 64, 64, wb + W_PA, 1024, (it >> 3) * 64, 1.f, lds, tid); return; }
    it -= 128;
    if (it < 128) { transpose_tile(P.in[I_PC] + (size_t)l * 512 * 1024, 1024, (it & 7) * 64, (it >> 3) * 64, 64, wb + W_PC, 1024, (it >> 3) * 64, 1.f, lds, tid); return; }
    it -= 128;
    if (it < 256) { transpose_tile(P.in[I_WOUT] + (size_t)l * 1024 * 1024, 1024, (it & 15) * 64, (it >> 4) * 64, 64, wb + W_OUT, 1024, (it >> 4) * 64, 1.f, lds, tid); return; }
    it -= 256;
    if (it < 1024) { transpose_tile(P.in[I_W1] + (size_t)l * 1024 * 4096, 4096, (it & 15) * 64, (it >> 4) * 64, 64, wb + W_1, 1024, (it >> 4) * 64, 1.f, lds, tid); return; }
    it -= 1024;
    transpose_tile(P.in[I_W2] + (size_t)l * 4096 * 1024, 1024, (it & 63) * 64, (it >> 6) * 64, 64, wb + W_2, 4096, (it >> 6) * 64, 1.f, lds, tid);
    return;
  }
  item -= 2 * PER_LAYER;
  if (item < 2) {
    const int l = item;
    float* bp = (float*)(P.ws + OFF_BINP) + l * N_INP;
    const float* b = P.in[I_BIN] + (size_t)l * N_IN;
    for (int n = tid; n < N_INP; n += NT) {
      float v = 0.f;
      if (n < 2048) v = b[n]; else if (n < 6912) v = b[n + 16]; else if (n < 6928) v = b[2048 + n - 6912];
      bp[n] = v;
    }
    return;
  }
  item -= 2;
  {
    const int bh = item & 1, cc = (item >> 1) % 48, l = item / 96;
    for (int idx = tid; idx < 1024 * 24; idx += NT) {
      const int k = idx / 24, b = idx - k * 24, bg = bh * 24 + b;
      const float c = (bg < 32) ? P.in[I_CP][bg * 1024 + k] : P.in[I_CS][(bg - 32) * 1024 + k];
      lds[idx] = c / (1.f + __expf(-c));
    }
    __syncthreads();
    const int cl = tid & 127, kq = tid >> 7, col = cc * 128 + cl;
    float acc[24];
#pragma unroll
    for (int b = 0; b < 24; ++b) acc[b] = 0.f;
    const float* w = P.in[I_ADAW] + (size_t)l * 1024 * 6144 + col;
    for (int k = kq * 256; k < kq * 256 + 256; ++k) {
      const float wv = w[(size_t)k * 6144];
      const float4* s4 = (const float4*)(lds + k * 24);
#pragma unroll
      for (int q = 0; q < 6; ++q) {
        const float4 s = s4[q];
        acc[4 * q] += wv * s.x; acc[4 * q + 1] += wv * s.y; acc[4 * q + 2] += wv * s.z; acc[4 * q + 3] += wv * s.w;
      }
    }
    __syncthreads();
#pragma unroll
    for (int b = 0; b < 24; ++b) lds[(kq * 24 + b) * 128 + cl] = acc[b];
    __syncthreads();
    float* mod = (float*)(P.ws + OFF_MOD);
    for (int idx = tid; idx < 24 * 128; idx += NT) {
      const int b = idx >> 7, c = idx & 127;
      const float v = lds[(0 * 24 + b) * 128 + c] + lds[(1 * 24 + b) * 128 + c] + lds[(2 * 24 + b) * 128 + c] + lds[(3 * 24 + b) * 128 + c] +
                      P.in[I_ADAB][l * 6144 + cc * 128 + c];
      mod[((size_t)(l * NSEQ_ALL + bh * 24 + b)) * 6144 + cc * 128 + c] = v;
    }
    __syncthreads();
  }
}
constexpr int PREP_ITEMS = 2 * 4800 + 2 + 192;

DI void phase_xm0(const Ctx& c) {
  const float* x = c.xin();
  bf16_t* xm = (bf16_t*)(c.ws() + OFF_R0);
  const size_t n8 = (size_t)TG * D / 8;
  for (size_t i = (size_t)c.bid * NT + c.tid; i < n8; i += (size_t)c.nb * NT) {
    const int row = (int)(i >> 7), col = (int)(i & 127) * 8;
    const float4 v0 = *(const float4*)(x + i * 8), v1 = *(const float4*)(x + i * 8 + 4);
    const float* scp = c.mod(1, row >> 11) + col; const float* shp = c.mod(0, row >> 11) + col;
    const float4 sc0 = *(const float4*)scp, sc1 = *(const float4*)(scp + 4), sh0 = *(const float4*)shp, sh1 = *(const float4*)(shp + 4);
    uint4 o;
    o.x = pack2(v0.x * (1.f + sc0.x) + sh0.x, v0.y * (1.f + sc0.y) + sh0.y); o.y = pack2(v0.z * (1.f + sc0.z) + sh0.z, v0.w * (1.f + sc0.w) + sh0.w);
    o.z = pack2(v1.x * (1.f + sc1.x) + sh1.x, v1.y * (1.f + sc1.y) + sh1.y); o.w = pack2(v1.z * (1.f + sc1.z) + sh1.z, v1.w * (1.f + sc1.w) + sh1.w);
    *(uint4*)(xm + i * 8) = o;
  }
}

DI void phase_conv(const Ctx& c) {
  const bf16_t* proj = (const bf16_t*)(c.ws() + OFF_R1);
  bf16_t* xc = (bf16_t*)(c.ws() + OFF_R2);
  float* wl = (float*)c.lds;
  for (int i = c.tid; i < 6 * 1024; i += NT) wl[i] = (i < 5120) ? c.in(I_CONVW)[(size_t)c.l * 5120 + i] : c.in(I_CONVB)[(size_t)c.l * 1024 + i - 5120];
  __syncthreads();
  const size_t n16 = (size_t)TG * 64, stride = (size_t)c.nb * NT;
  const int ch = (c.tid & 63) * 16;
  size_t i = (size_t)c.bid * NT + c.tid;
  uint4 v[5][2], nv[5][2];
  auto load_rows = [&](size_t idx, uint4 (&dst)[5][2]) {
    const int row = (int)(idx >> 6), s = row & (SEQ - 1);
#pragma unroll
    for (int tp = 0; tp < 5; ++tp) {
      const int ss = s + tp - 2;
      if (ss >= 0 && ss < SEQ) {
        const bf16_t* p = proj + (size_t)(row + tp - 2) * LDP + P_XM + ch;
        dst[tp][0] = *(const uint4*)p; dst[tp][1] = *(const uint4*)(p + 8);
      } else { dst[tp][0] = make_uint4(0, 0, 0, 0); dst[tp][1] = make_uint4(0, 0, 0, 0); }
    }
  };
  if (i < n16) load_rows(i, v);
  for (; i < n16; i += stride) {
    const int row = (int)(i >> 6);
    const bool more = i + stride < n16;
    if (more) load_rows(i + stride, nv);
    uint4 o[2];
#pragma unroll
    for (int hh = 0; hh < 2; ++hh) {
      float acc[8];
      const int c0 = ch + hh * 8;
      const float4 cb0 = *(const float4*)(wl + 5120 + c0), cb1 = *(const float4*)(wl + 5120 + c0 + 4);
      acc[0] = cb0.x; acc[1] = cb0.y; acc[2] = cb0.z; acc[3] = cb0.w; acc[4] = cb1.x; acc[5] = cb1.y; acc[6] = cb1.z; acc[7] = cb1.w;
#pragma unroll
      for (int tp = 0; tp < 5; ++tp) {
        const uint4 u = v[tp][hh];
        const float4 w0 = *(const float4*)(wl + tp * 1024 + c0), w1 = *(const float4*)(wl + tp * 1024 + c0 + 4);
        acc[0] += lo2f(u.x) * w0.x; acc[1] += hi2f(u.x) * w0.y; acc[2] += lo2f(u.y) * w0.z; acc[3] += hi2f(u.y) * w0.w;
        acc[4] += lo2f(u.z) * w1.x; acc[5] += hi2f(u.z) * w1.y; acc[6] += lo2f(u.w) * w1.z; acc[7] += hi2f(u.w) * w1.w;
      }
#pragma unroll
      for (int j = 0; j < 8; ++j) acc[j] = acc[j] * sigmoidf_(acc[j]);
      o[hh].x = pack2(acc[0], acc[1]); o[hh].y = pack2(acc[2], acc[3]); o[hh].z = pack2(acc[4], acc[5]); o[hh].w = pack2(acc[6], acc[7]);
    }
    *(uint4*)(xc + (size_t)row * 1024 + ch) = o[0]; *(uint4*)(xc + (size_t)row * 1024 + ch + 8) = o[1];
    if (more) {
#pragma unroll
      for (int tp = 0; tp < 5; ++tp) { v[tp][0] = nv[tp][0]; v[tp][1] = nv[tp][1]; }
    }
  }
  __syncthreads();
}

DI void phase_post(const Ctx& c) {
  const bf16_t* hf = (const bf16_t*)(c.ws() + OFF_R0);
  bf16_t* hb = (bf16_t*)(c.ws() + OFF_R2);
  const bf16_t* proj = (const bf16_t*)(c.ws() + OFF_R1);
  const float* nw = c.in(I_NORMW) + (size_t)c.l * 1024;
  const int lane = c.tid & 63;
  const int gw = c.bid * (NT / 64) + (c.tid >> 6), nw_ = c.nb * (NT / 64);
  float4 wv[4];
#pragma unroll
  for (int hd = 0; hd < 4; ++hd) wv[hd] = *(const float4*)(nw + hd * 256 + lane * 4);
  for (int idx0 = gw * 4; idx0 < TG * 4; idx0 += nw_ * 4) {
    uint2 a[4], b[4], z[4];
#pragma unroll
    for (int rr = 0; rr < 4; ++rr) {
      const int row = (idx0 + rr) >> 2, head = (idx0 + rr) & 3;
      const size_t base = (size_t)row * 1024 + head * 256 + lane * 4;
      a[rr] = *(const uint2*)(hf + base); b[rr] = *(const uint2*)(hb + base);
      z[rr] = *(const uint2*)(proj + (size_t)row * LDP + P_Z + head * 256 + lane * 4);
    }
#pragma unroll
    for (int rr = 0; rr < 4; ++rr) {
      const int row = (idx0 + rr) >> 2, head = (idx0 + rr) & 3;
      const size_t base = (size_t)row * 1024 + head * 256 + lane * 4;
      float x0 = lo2f(a[rr].x) + lo2f(b[rr].x), x1 = hi2f(a[rr].x) + hi2f(b[rr].x), x2 = lo2f(a[rr].y) + lo2f(b[rr].y), x3 = hi2f(a[rr].y) + hi2f(b[rr].y);
      const float mean = wsum(x0 + x1 + x2 + x3, lane) * (1.f / 256.f);
      x0 -= mean; x1 -= mean; x2 -= mean; x3 -= mean;
      const float var = wsum(x0 * x0 + x1 * x1 + x2 * x2 + x3 * x3, lane) * (1.f / 256.f);
      const float rstd = rsqrtf(var + LN_EPS);
      const float4 w = wv[rr];
      uint2 o;
      o.x = pack2(x0 * rstd * w.x * sigmoidf_(lo2f(z[rr].x)), x1 * rstd * w.y * sigmoidf_(hi2f(z[rr].x)));
      o.y = pack2(x2 * rstd * w.z * sigmoidf_(lo2f(z[rr].y)), x3 * rstd * w.w * sigmoidf_(hi2f(z[rr].y)));
      *(uint2*)(hb + base) = o;
    }
  }
}

template <bool MID>
DI void phase_ln(const Ctx& c, const bf16_t* pre, const float* xres, const float* w, const float* b, int mod_layer, int mod_sh, int mod_sc) {
  float* xo = c.xout();
  bf16_t* x1b = (bf16_t*)(c.ws() + OFF_R2);
  bf16_t* xm = (bf16_t*)(c.ws() + OFF_R0);
  const int lane = c.tid & 63;
  const int gw = c.bid * (NT / 64) + (c.tid >> 6), nw_ = c.nb * (NT / 64);
  float4 ww[4], bb[4];
#pragma unroll
  for (int i = 0; i < 4; ++i) { ww[i] = *(const float4*)(w + i * 256 + lane * 4); bb[i] = *(const float4*)(b + i * 256 + lane * 4); }
  for (int row0 = gw * 4; row0 < TG; row0 += nw_ * 4) {
    float4 v[4][4], sc[4], sh[4];
    const float* modbase = (const float*)(c.ws() + OFF_MOD) + ((size_t)((mod_layer < 0 ? 0 : mod_layer) * NSEQ_ALL + c.g * GSEQ + (row0 >> 11))) * 6144;
#pragma unroll
    for (int rr = 0; rr < 4; ++rr)
#pragma unroll
      for (int i = 0; i < 4; ++i) {
        const size_t off = (size_t)(row0 + rr) * 1024 + i * 256 + lane * 4;
        const uint2 pv = *(const uint2*)(pre + off);
        float4 xv;
        if (MID) xv = *(const float4*)(xres + off);
        else { const uint2 xb = *(const uint2*)(x1b + off); xv.x = lo2f(xb.x); xv.y = hi2f(xb.x); xv.z = lo2f(xb.y); xv.w = hi2f(xb.y); }
        v[rr][i].x = ALPHA * xv.x + lo2f(pv.x); v[rr][i].y = ALPHA * xv.y + hi2f(pv.x); v[rr][i].z = ALPHA * xv.z + lo2f(pv.y); v[rr][i].w = ALPHA * xv.w + hi2f(pv.y);
      }
    if (mod_layer >= 0) {
#pragma unroll
      for (int i = 0; i < 4; ++i) { sc[i] = *(const float4*)(modbase + mod_sc * 1024 + i * 256 + lane * 4); sh[i] = *(const float4*)(modbase + mod_sh * 1024 + i * 256 + lane * 4); }
    }
#pragma unroll
    for (int rr = 0; rr < 4; ++rr) {
      float s = 0.f;
#pragma unroll
      for (int i = 0; i < 4; ++i) s += v[rr][i].x + v[rr][i].y + v[rr][i].z + v[rr][i].w;
      const float mean = wsum(s, lane) * (1.f / 1024.f);
      float q = 0.f;
#pragma unroll
      for (int i = 0; i < 4; ++i) { float4& t = v[rr][i]; t.x -= mean; t.y -= mean; t.z -= mean; t.w -= mean; q += t.x * t.x + t.y * t.y + t.z * t.z + t.w * t.w; }
      const float rstd = rsqrtf(wsum(q, lane) * (1.f / 1024.f) + LN_EPS);
#pragma unroll
      for (int i = 0; i < 4; ++i) {
        float4& t = v[rr][i];
        t.x = t.x * rstd * ww[i].x + bb[i].x; t.y = t.y * rstd * ww[i].y + bb[i].y; t.z = t.z * rstd * ww[i].z + bb[i].z; t.w = t.w * rstd * ww[i].w + bb[i].w;
      }
    }
    asm volatile("" ::: "memory");
#pragma unroll
    for (int rr = 0; rr < 4; ++rr)
#pragma unroll
      for (int i = 0; i < 4; ++i) {
        const size_t off = (size_t)(row0 + rr) * 1024 + i * 256 + lane * 4;
        const float4 y = v[rr][i];
        if (MID) { uint2 xb; xb.x = pack2(y.x, y.y); xb.y = pack2(y.z, y.w); *(uint2*)(x1b + off) = xb; }
        else *(float4*)(xo + off) = y;
        if (mod_layer >= 0) {
          uint2 o; o.x = pack2(y.x * (1.f + sc[i].x) + sh[i].x, y.y * (1.f + sc[i].y) + sh[i].y); o.y = pack2(y.z * (1.f + sc[i].z) + sh[i].z, y.w * (1.f + sc[i].w) + sh[i].w);
          *(uint2*)(xm + off) = o;
        }
      }
  }
}

DI void phase_g1(const Ctx& c) {
  const char* xm = (const char*)(c.ws() + OFF_R0);
  bf16_t* proj = (bf16_t*)(c.ws() + OFF_R1);
  float* gates = (float*)(c.ws() + OFF_GATES);
  const float* binp = (const float*)(c.ws() + OFF_BINP) + c.l * N_INP;
  const char* wt = (const char*)c.W(W_IN);
  constexpr int nM = TG / 256, nN = N_INP / 256;
  auto sched = [&](int i, GUnit& u) -> bool {
    const int L = i * c.nb + c.bid; if (L >= nM * nN) return false;
    static_unit(L, nM, nN, u.pm, u.pn);
    u.A = xm + (size_t)u.pm * 256 * 1024 * 2; u.B = wt + (size_t)u.pn * 256 * 1024 * 2; u.nt = 16; u.tag = 0; return true; };
  auto epi = [&](GAcc& acc, const GUnit& u, int wr, int wc, int fr, int fq) -> bool {
    const int m0 = u.pm * 256, n0 = u.pn * 256;
    const ColVec bv = load_cols(binp + n0, wc, fq);
    if (n0 < P_U) {
      for_rows8b(acc, wr, wc, fr, fq, [&](int rl, int cl, int bj, f32x4 v0, f32x4 v1) {
        *(uint4*)(proj + (size_t)(m0 + rl) * LDP + n0 + cl) = pack8(v0 + bv.v[bj][0], v1 + bv.v[bj][1]); });
    } else if (n0 < P_G) {
      for_rows8b(acc, wr, wc, fr, fq, [&](int rl, int cl, int bj, f32x4 v0, f32x4 v1) {
        v0 += bv.v[bj][0]; v1 += bv.v[bj][1];
#pragma unroll
        for (int j = 0; j < 4; ++j) { v0[j] = gelu_tanh(v0[j]); v1[j] = gelu_tanh(v1[j]); }
        *(uint4*)(proj + (size_t)(m0 + rl) * LDP + n0 + cl) = pack8(v0, v1); });
    } else if (n0 < LDP) {
      for_rows8b(acc, wr, wc, fr, fq, [&](int rl, int cl, int bj, f32x4 v0, f32x4 v1) {
        v0 += bv.v[bj][0]; v1 += bv.v[bj][1];
#pragma unroll
        for (int j = 0; j < 4; ++j) { v0[j] = sigmoidf_(v0[j]); v1[j] = sigmoidf_(v1[j]); }
        *(uint4*)(proj + (size_t)(m0 + rl) * LDP + n0 + cl) = pack8(v0, v1); });
    } else {
      for_rows8b(acc, wr, wc, fr, fq, [&](int rl, int cl, int bj, f32x4 v0, f32x4 v1) {
        if (cl < 16) {
          float* o = gates + (size_t)(m0 + rl) * 16 + cl;
          *(f32x4*)o = v0 + bv.v[bj][0]; *(f32x4*)(o + 4) = v1 + bv.v[bj][1];
        } });
    }
    return false;
  };
  gemm_phase8(c.lds, 1024, 1024, sched, epi, c.tid);
}

DI void phase_g2(const Ctx& c) {
  const char* xc = (const char*)(c.ws() + OFF_R2);
  const char* proj = (const char*)(c.ws() + OFF_R1);
  bf16_t* mq = (bf16_t*)(c.ws() + OFF_R3);
  bf16_t* mk = mq + (size_t)TG * 1024;
  bf16_t* mkt = mk + (size_t)TG * 1024;
  bf16_t* mvt = mkt + (size_t)TG * 1024;
  const char* wqkv = (const char*)c.W(W_QKV);
  constexpr int nM = TG / 256;
  {
    auto sched = [&](int i, GUnit& u) -> bool {
      const int L = i * c.nb + c.bid; if (L >= nM * 8) return false;
      u.pm = L >> 3; u.pn = L & 3; u.tag = (L >> 2) & 1;
      u.A = xc + ((size_t)u.pm * 256 * 1024 + u.pn * 256) * 2; u.B = wqkv + (size_t)(u.tag * 4 + u.pn) * 65536 * 2; u.nt = 4; return true; };
    auto epi = [&](GAcc& acc, const GUnit& u, int wr, int wc, int fr, int fq) -> bool {
      bf16_t* dst = (u.tag ? mk : mq) + (size_t)u.pm * 256 * 1024 + u.pn * 256;
      for_rows8(acc, wr, wc, fr, fq, [&](int rl, int cl, f32x4 v0, f32x4 v1) { *(uint4*)(dst + (size_t)rl * 1024 + cl) = pack8(v0, v1); }); return false; };
    int t1 = c.tid; asm volatile("" : "+v"(t1));
    gemm_phase8(c.lds, 1024, 256, sched, epi, t1);
  }
  {
    auto sched = [&](int i, GUnit& u) -> bool {
      const int L = i * c.nb + c.bid; if (L >= nM * 4) return false;
      u.pm = L >> 2; u.pn = L & 3; u.tag = 0;
      u.A = wqkv + (size_t)(4 + u.pn) * 65536 * 2; u.B = xc + ((size_t)u.pm * 256 * 1024 + u.pn * 256) * 2; u.nt = 4; return true; };
    auto epi = [&](GAcc& acc, const GUnit& u, int wr, int wc, int fr, int fq) -> bool {
      const int tok0 = u.pm * 256, seq = tok0 >> 11, s0 = tok0 & (SEQ - 1);
      bf16_t* dst = mkt + ((size_t)(seq * 4 + u.pn) * 256) * SEQ + s0;
      for_rows8(acc, wr, wc, fr, fq, [&](int rl, int cl, f32x4 v0, f32x4 v1) { *(uint4*)(dst + (size_t)rl * SEQ + cl) = pack8(v0, v1); }); return false; };
    int t2 = c.tid; asm volatile("" : "+v"(t2));
    gemm_phase8(c.lds, 256, 1024, sched, epi, t2);
  }
  {
    auto sched = [&](int i, GUnit& u) -> bool {
      const int L = i * c.nb + c.bid; if (L >= nM * 4) return false;
      u.pm = L >> 2; u.pn = L & 3; u.tag = 0;
      u.A = wqkv + (size_t)(8 + u.pn) * 65536 * 2; u.B = proj + ((size_t)u.pm * 256 * LDP + P_XM + u.pn * 256) * 2; u.nt = 4; return true; };
    auto epi = [&](GAcc& acc, const GUnit& u, int wr, int wc, int fr, int fq) -> bool {
      const int tok0 = u.pm * 256, seq = tok0 >> 11, s0 = tok0 & (SEQ - 1);
      bf16_t* dst = mvt + ((size_t)(seq * 4 + u.pn) * 256) * SEQ + s0;
      for_rows8(acc, wr, wc, fr, fq, [&](int rl, int cl, f32x4 v0, f32x4 v1) { *(uint4*)(dst + (size_t)rl * SEQ + cl) = pack8(v0, v1); }); return false; };
    int t3 = c.tid; asm volatile("" : "+v"(t3));
    gemm_phase8(c.lds, 256, LDP, sched, epi, t3);
  }
}

DI void phase_merge(const Ctx& c) {
  const char* ym = (const char*)(c.ws() + OFF_R2);
  const char* yac = (const char*)(c.ws() + OFF_R5);
  const bf16_t* proj = (const bf16_t*)(c.ws() + OFF_R1);
  bf16_t* merged = (bf16_t*)(c.ws() + OFF_R3);
  const char* wpm = (const char*)c.W(W_PM);
  const char* wpa = (const char*)c.W(W_PA);
  constexpr int nM = TG / 256, nN = 4;
  auto sched = [&](int i, GUnit& u) -> bool {
    const int j = i / 3, b = i - j * 3;
    const int L = j * c.nb + c.bid; if (L >= nM * nN) return false;
    static_unit(L, nM, nN, u.pm, u.pn);
    u.tag = b; u.nt = (b == 0) ? 16 : 8;
    u.A = ((b == 0) ? ym : yac + (b == 2 ? 1024 : 0)) + (size_t)u.pm * 256 * 1024 * 2;
    u.B = ((b == 0) ? wpm : wpa + (b == 2 ? 1024 : 0)) + (size_t)u.pn * 256 * 1024 * 2;
    return true; };
  auto epi = [&](GAcc& acc, const GUnit& u, int wr, int wc, int fr, int fq) -> bool {
    const int m0 = u.pm * 256, n0 = u.pn * 256, b = u.tag;
    const bf16_t* gp = proj + (size_t)(m0 + wr * 64 + fr) * LDP + P_G + b * 1024 + n0 + wc * 32 + 8 * fq;
#pragma unroll
    for (int ai = 0; ai < 2; ++ai) {
      uint4 g[4][2], gn[4][2];
#pragma unroll
      for (int m = 0; m < 4; ++m)
#pragma unroll
        for (int bj = 0; bj < 2; ++bj) {
          const bf16_t* q = gp + (size_t)(ai * 128 + m * 16) * LDP + bj * 128;
          g[m][bj] = *(const uint4*)q;
          if (b < 2) gn[m][bj] = *(const uint4*)(q + 1024);
        }
#pragma unroll
      for (int m = 0; m < 4; ++m)
#pragma unroll
        for (int bj = 0; bj < 2; ++bj) {
          const uint4 gg = g[m][bj];
          f32x4 g0 = {lo2f(gg.x), hi2f(gg.x), lo2f(gg.y), hi2f(gg.y)}, g1 = {lo2f(gg.z), hi2f(gg.z), lo2f(gg.w), hi2f(gg.w)};
          if (b < 2) {
            const uint4 hh = gn[m][bj];
            const f32x4 h0 = {lo2f(hh.x), hi2f(hh.x), lo2f(hh.y), hi2f(hh.y)}, h1 = {lo2f(hh.z), hi2f(hh.z), lo2f(hh.w), hi2f(hh.w)};
#pragma unroll
            for (int j = 0; j < 4; ++j) { g0[j] *= __builtin_amdgcn_rcpf(fmaxf(h0[j], 1e-30f)); g1[j] *= __builtin_amdgcn_rcpf(fmaxf(h1[j], 1e-30f)); }
            acc[ai][bj][m][0] *= g0; acc[ai][bj][m][1] *= g1;
          } else {
            const size_t row = m0 + ai * 128 + wr * 64 + m * 16 + fr; const int col = n0 + bj * 128 + wc * 32 + 8 * fq;
            *(uint4*)(merged + row * 1024 + col) = pack8(g0 * acc[ai][bj][m][0], g1 * acc[ai][bj][m][1]);
          }
        }
    }
    return b < 2;
  };
  gemm_phase8(c.lds, 1024, 1024, sched, epi, c.tid);
}

DI void phase_wout(const Ctx& c) {
  const char* merged = (const char*)(c.ws() + OFF_R3);
  bf16_t* pre = (bf16_t*)(c.ws() + OFF_R3 + 64 * MiB);
  const char* wt = (const char*)c.W(W_OUT);
  constexpr int nM = TG / 256, nN = 4;
  auto sched = [&](int i, GUnit& u) -> bool {
    const int L = i * c.nb + c.bid; if (L >= nM * nN) return false;
    static_unit(L, nM, nN, u.pm, u.pn);
    u.A = merged + (size_t)u.pm * 256 * 1024 * 2; u.B = wt + (size_t)u.pn * 256 * 1024 * 2; u.nt = 16; u.tag = 0; return true; };
  auto epi = [&](GAcc& acc, const GUnit& u, int wr, int wc, int fr, int fq) -> bool {
    const int m0 = u.pm * 256, n0 = u.pn * 256;
    const ColVec gv = load_cols(c.mod(2, m0 >> 11) + n0, wc, fq);
    for_rows8b(acc, wr, wc, fr, fq, [&](int rl, int cl, int bj, f32x4 v0, f32x4 v1) {
      const size_t off = (size_t)(m0 + rl) * 1024 + n0 + cl;
      *(uint4*)(pre + off) = pack8((gv.v[bj][0] + 1.f) * v0, (gv.v[bj][1] + 1.f) * v1); }); return false; };
  gemm_phase8(c.lds, 1024, 1024, sched, epi, c.tid);
}

DI void phase_mlp1(const Ctx& c) {
  const char* xm = (const char*)(c.ws() + OFF_R0);
  bf16_t* hid = (bf16_t*)(c.ws() + OFF_R1);
  const float* b1 = c.in(I_B1) + (size_t)c.l * 4096;
  const char* wt = (const char*)c.W(W_1);
  constexpr int nM = TG / 256, nN = 16;
  auto sched = [&](int i, GUnit& u) -> bool {
    const int L = i * c.nb + c.bid; if (L >= nM * nN) return false;
    static_unit(L, nM, nN, u.pm, u.pn);
    u.A = xm + (size_t)u.pm * 256 * 1024 * 2; u.B = wt + (size_t)u.pn * 256 * 1024 * 2; u.nt = 16; u.tag = 0; return true; };
  auto epi = [&](GAcc& acc, const GUnit& u, int wr, int wc, int fr, int fq) -> bool {
    const int m0 = u.pm * 256, n0 = u.pn * 256;
    const ColVec bv = load_cols(b1 + n0, wc, fq);
    for_rows8b(acc, wr, wc, fr, fq, [&](int rl, int cl, int bj, f32x4 v0, f32x4 v1) {
      v0 += bv.v[bj][0]; v1 += bv.v[bj][1];
#pragma unroll
      for (int j = 0; j < 4; ++j) { const float a = fmaxf(v0[j], 0.f), b = fmaxf(v1[j], 0.f); v0[j] = a * a; v1[j] = b * b; }
      *(uint4*)(hid + (size_t)(m0 + rl) * 4096 + n0 + cl) = pack8(v0, v1); }); return false; };
  gemm_phase8(c.lds, 1024, 1024, sched, epi, c.tid);
}

DI void phase_mlp2(const Ctx& c) {
  const char* hid = (const char*)(c.ws() + OFF_R1);
  bf16_t* pre = (bf16_t*)(c.ws() + OFF_R1 + 256 * MiB);
  const float* b2 = c.in(I_B2) + (size_t)c.l * 1024;
  const char* wt = (const char*)c.W(W_2);
  constexpr int nM = TG / 256, nN = 4;
  auto sched = [&](int i, GUnit& u) -> bool {
    const int L = i * c.nb + c.bid; if (L >= nM * nN) return false;
    static_unit(L, nM, nN, u.pm, u.pn);
    u.A = hid + (size_t)u.pm * 256 * 4096 * 2; u.B = wt + (size_t)u.pn * 256 * 4096 * 2; u.nt = 64; u.tag = 0; return true; };
  auto epi = [&](GAcc& acc, const GUnit& u, int wr, int wc, int fr, int fq) -> bool {
    const int m0 = u.pm * 256, n0 = u.pn * 256;
    const ColVec gv = load_cols(c.mod(5, m0 >> 11) + n0, wc, fq), bv = load_cols(b2 + n0, wc, fq);
    for_rows8b(acc, wr, wc, fr, fq, [&](int rl, int cl, int bj, f32x4 v0, f32x4 v1) {
      const size_t off = (size_t)(m0 + rl) * 1024 + n0 + cl;
      *(uint4*)(pre + off) = pack8((gv.v[bj][0] + 1.f) * (v0 + bv.v[bj][0]), (gv.v[bj][1] + 1.f) * (v1 + bv.v[bj][1])); }); return false; };
  gemm_phase8(c.lds, 4096, 4096, sched, epi, c.tid);
}

DI void gate_prepass(const Ctx& c) {
  const float* gates = (const float*)(c.ws() + OFF_GATES);
  float* ga = (float*)(c.ws() + OFF_GPRE);
  float* gb = ga + 128 * SEQ; float* gc = gb + 128 * SEQ; float* gt = gc + 128 * SEQ;
  const int lane = c.tid & 63;
  const int gw = c.bid * (NT / 64) + (c.tid >> 6), nw_ = c.nb * (NT / 64);
  for (int idx = gw; idx < GSEQ * 4 * 2 * 32; idx += nw_) {
    const int cj = idx & 31, dir = (idx >> 5) & 1, head = (idx >> 6) & 3, seq = idx >> 8;
    const int p = dir ? 63 - lane : lane;
    const int t = seq * SEQ + cj * 64 + p;
    const float ig = gates[(size_t)t * 16 + dir * 8 + head];
    const float fg = gates[(size_t)t * 16 + dir * 8 + 4 + head];
    float a = fminf(fg, 0.f) - log1pf(__expf(-fabsf(fg)));
#pragma unroll
    for (int o = 1; o < 64; o <<= 1) { const float tt = bperm(lane - o, a); if (lane >= o) a += tt; }
    const float b = ig - a;
    float cmb = b;
#pragma unroll
    for (int o = 1; o < 64; o <<= 1) { const float tt = bperm(lane - o, cmb); if (lane >= o) cmb = fmaxf(cmb, tt); }
    const size_t base = (size_t)((seq * 4 + head) * 2 + dir) * SEQ + cj * 64 + p;
    ga[base] = a; gb[base] = b; gc[base] = cmb;
    if (lane == 63) { float* g2 = gt + ((seq * 4 + head) * 2 + dir) * 64 + cj * 2; g2[0] = a; g2[1] = cmb; }
  }
}

#define MFMA16(a, b, c) __builtin_amdgcn_mfma_f32_16x16x32_bf16((a), (b), (c), 0, 0, 0)
DI bf16x8 frag_from(uint2 lo, uint2 hi) { uint4 u; u.x = lo.x; u.y = lo.y; u.z = hi.x; u.w = hi.y; return __builtin_bit_cast(bf16x8, u); }
DI bf16x8 frag_pack(f32x4 lo, f32x4 hi) { uint4 u; u.x = pack2(lo[0], lo[1]); u.y = pack2(lo[2], lo[3]); u.z = pack2(hi[0], hi[1]); u.w = pack2(hi[2], hi[3]); return __builtin_bit_cast(bf16x8, u); }

DI void scan_item(const Ctx& c, int item) {
  const int vh = item & 1, dir = (item >> 1) & 1, head = (item >> 2) & 3, seq = item >> 4;
  const int tid = c.tid, lane = tid & 63, wave = tid >> 6, n16 = lane & 15, q4 = lane >> 4;
  const bf16_t* mq = (const bf16_t*)(c.ws() + OFF_R3);
  const bf16_t* mk = mq + (size_t)TG * 1024;
  const bf16_t* mkt = mk + (size_t)TG * 1024;
  const bf16_t* mvt = mkt + (size_t)TG * 1024;
  const float* gpre = (const float*)(c.ws() + OFF_GPRE);
  bf16_t* hout = (bf16_t*)(c.ws() + (dir ? OFF_R2 : OFF_R0));
  bf16_t* Qs = c.lds;
  bf16_t* Ks = Qs + 16896;
  bf16_t* KTs = Ks + 16896;
  bf16_t* VT = KTs + 18432;
  bf16_t* VTs = VT + 9216;
  bf16_t* Ps = VTs + 9216;
  float* fl = (float*)(Ps + 4608);
  float* ns = fl;
  float* abc_s = fl + 256;
  float* a_s = abc_s; float* b_s = abc_s + 64; float* c_s = abc_s + 128;
  float* wg_s = abc_s + 192; float* den_s = wg_s + 64; float* gt_s = den_s + 64; float* winter_s = gt_s + 64; float* emrow_s = winter_s + 64;

  f32x4 cst[16];
#pragma unroll
  for (int kt = 0; kt < 16; ++kt) cst[kt] = (f32x4){0.f, 0.f, 0.f, 0.f};
  float nreg = 0.f, mstate = 0.f;
  if (tid < 256) ns[tid] = 0.f;
  const int gidx = (seq * 4 + head) * 2 + dir;
  if (tid < 64) gt_s[tid] = gpre[(size_t)3 * 128 * SEQ + gidx * 64 + tid];
  const size_t tbase = (size_t)(seq * 4 + head) * 256;
  const int lrow = tid >> 5, lkc = (tid & 31) * 8;
  const bf16_t* qsrc = mq + (size_t)(seq * SEQ + lrow) * 1024 + head * 256 + lkc;
  const bf16_t* ksrc = mk + (size_t)(seq * SEQ + lrow) * 1024 + head * 256 + lkc;
  const bf16_t* vsrc = mvt + (tbase + vh * 128 + (tid >> 3)) * SEQ + (tid & 7) * 8;
  const bf16_t* ktsrc = mkt + (tbase + (tid >> 3)) * SEQ + (tid & 7) * 8;
  const float* gsrc = gpre + (size_t)(tid >> 6) * 128 * SEQ + (size_t)gidx * SEQ + (tid & 63);
  uint4 rq0, rq1, rq2, rq3, rk0, rk1, rk2, rk3, rt0, rt1, rt2, rt3, rv0, rv1; float rg = 0.f;
#define PF_QK(cn) do { const size_t o_ = (size_t)(cn) * 64 * 1024; \
    rq0 = *(const uint4*)(qsrc + o_); rq1 = *(const uint4*)(qsrc + o_ + 16 * 1024); rq2 = *(const uint4*)(qsrc + o_ + 32 * 1024); rq3 = *(const uint4*)(qsrc + o_ + 48 * 1024); \
    rk0 = *(const uint4*)(ksrc + o_); rk1 = *(const uint4*)(ksrc + o_ + 16 * 1024); rk2 = *(const uint4*)(ksrc + o_ + 32 * 1024); rk3 = *(const uint4*)(ksrc + o_ + 48 * 1024); } while (0)
#define PF_TV(cn) do { \
    rt0 = *(const uint4*)(ktsrc + (cn) * 64); rt1 = *(const uint4*)(ktsrc + (size_t)64 * SEQ + (cn) * 64); \
    rt2 = *(const uint4*)(ktsrc + (size_t)128 * SEQ + (cn) * 64); rt3 = *(const uint4*)(ktsrc + (size_t)192 * SEQ + (cn) * 64); \
    rv0 = *(const uint4*)(vsrc + (cn) * 64); rv1 = *(const uint4*)(vsrc + (size_t)64 * SEQ + (cn) * 64); \
    if (tid < 192) rg = gsrc[(cn) * 64]; } while (0)
#define PUT_QK() do { bf16_t* qd = Qs + lrow * 264 + lkc; bf16_t* kd = Ks + lrow * 264 + lkc; \
    *(uint4*)(qd) = rq0; *(uint4*)(qd + 16 * 264) = rq1; *(uint4*)(qd + 32 * 264) = rq2; *(uint4*)(qd + 48 * 264) = rq3; \
    *(uint4*)(kd) = rk0; *(uint4*)(kd + 16 * 264) = rk1; *(uint4*)(kd + 32 * 264) = rk2; *(uint4*)(kd + 48 * 264) = rk3; } while (0)
  PF_QK(dir ? 31 : 0); PF_TV(dir ? 31 : 0);
  PUT_QK();
  __syncthreads();

#pragma unroll 1
  for (int j = 0; j < 32; ++j) {
    const int cj = dir ? 31 - j : j;
    const int t0 = seq * SEQ + cj * 64;
    const float Atot = gt_s[cj * 2], cmbl = gt_s[cj * 2 + 1];
    const float m_new = Atot + fmaxf(mstate, cmbl);
    const float decay = __expf(Atot + mstate - m_new);
    {
      bf16_t* kw = KTs + (tid >> 3) * 72 + (tid & 7) * 8;
      *(uint4*)(kw) = rt0; *(uint4*)(kw + 64 * 72) = rt1; *(uint4*)(kw + 128 * 72) = rt2; *(uint4*)(kw + 192 * 72) = rt3;
      bf16_t* vw = VT + (tid >> 3) * 72 + (tid & 7) * 8;
      *(uint4*)(vw) = rv0; *(uint4*)(vw + 64 * 72) = rv1;
      if (tid < 192) abc_s[tid] = rg;
      if (tid >= 128 && tid < 192) winter_s[tid - 128] = __expf(mstate - fmaxf(mstate, rg));
    }
    __syncthreads();
    {
      const int sc = (tid & 7) * 8;
      const float4 q0 = *(const float4*)(b_s + sc), q1 = *(const float4*)(b_s + sc + 4);
      const float e0 = Atot - m_new;
      const float w0 = __expf(e0 + q0.x), w1 = __expf(e0 + q0.y), w2 = __expf(e0 + q0.z), w3 = __expf(e0 + q0.w);
      const float w4_ = __expf(e0 + q1.x), w5 = __expf(e0 + q1.y), w6 = __expf(e0 + q1.z), w7 = __expf(e0 + q1.w);
#pragma unroll
      for (int i = 0; i < 2; ++i) {
        const int v = (tid >> 3) + 64 * i;
        const uint4 raw = *(const uint4*)(VT + v * 72 + sc);
        uint4 o;
        o.x = pack2(lo2f(raw.x) * w0, hi2f(raw.x) * w1); o.y = pack2(lo2f(raw.y) * w2, hi2f(raw.y) * w3);
        o.z = pack2(lo2f(raw.z) * w4_, hi2f(raw.z) * w5); o.w = pack2(lo2f(raw.w) * w6, hi2f(raw.w) * w7);
        *(uint4*)(VTs + v * 72 + sc) = o;
      }
      if (tid < 64) { wg_s[tid] = __expf(e0 + b_s[tid]); emrow_s[tid] = __expf(-(a_s[tid] + fmaxf(mstate, c_s[tid]))); }
    }
    {
      const int lt = wave >> 1, st0 = (wave & 1) * 2;
      f32x4 sacc0 = {0.f, 0.f, 0.f, 0.f}, sacc1 = {0.f, 0.f, 0.f, 0.f};
      const bf16_t* ap = Qs + (16 * lt + n16) * 264 + 8 * q4;
      const bf16_t* bp = Ks + (16 * st0 + n16) * 264 + 8 * q4;
#pragma unroll
      for (int kk = 0; kk < 8; ++kk) {
        const bf16x8 a = *(const bf16x8*)(ap + 32 * kk);
        sacc0 = MFMA16(a, *(const bf16x8*)(bp + 32 * kk), sacc0);
        sacc1 = MFMA16(a, *(const bf16x8*)(bp + 16 * 264 + 32 * kk), sacc1);
      }
#pragma unroll
      for (int i = 0; i < 2; ++i) {
        const int scol = 16 * (st0 + i) + n16;
        const float bcol = b_s[scol];
#pragma unroll
        for (int jj = 0; jj < 4; ++jj) {
          const int lr = 16 * lt + 4 * q4 + jj;
          const bool valid = dir ? (scol >= lr) : (scol <= lr);
          const float sv = i ? sacc1[jj] : sacc0[jj];
          const float pv = valid ? sv * __expf(bcol - fmaxf(mstate, c_s[lr])) : 0.f;
          Ps[lr * 72 + scol] = f2bf(pv);
        }
      }
    }
    f32x4 iacc[4];
#pragma unroll
    for (int lt = 0; lt < 4; ++lt) iacc[lt] = (f32x4){0.f, 0.f, 0.f, 0.f};
#pragma unroll
    for (int kb = 0; kb < 8; ++kb) {
      const bf16x8 bfrag = frag_pack(cst[2 * kb], cst[2 * kb + 1]);
#pragma unroll
      for (int lt = 0; lt < 4; ++lt) {
        const bf16_t* qp = Qs + (16 * lt + n16) * 264 + 32 * kb + 4 * q4;
        iacc[lt] = MFMA16(frag_from(*(const uint2*)qp, *(const uint2*)(qp + 16)), bfrag, iacc[lt]);
      }
      __builtin_amdgcn_sched_barrier(0);
    }
#pragma unroll
    for (int lt = 0; lt < 4; ++lt) iacc[lt] *= *(const f32x4*)(winter_s + 16 * lt + 4 * q4);
    __syncthreads();
    if (j + 1 < 32) { PF_QK(dir ? cj - 1 : cj + 1); PF_TV(dir ? cj - 1 : cj + 1); }
#pragma unroll
    for (int ss = 0; ss < 2; ++ss) {
      const bf16x8 b = *(const bf16x8*)(VT + (16 * wave + n16) * 72 + 32 * ss + 8 * q4);
#pragma unroll
      for (int lt = 0; lt < 4; ++lt) iacc[lt] = MFMA16(*(const bf16x8*)(Ps + (16 * lt + n16) * 72 + 32 * ss + 8 * q4), b, iacc[lt]);
    }
    {
      const int l = tid >> 3, part = tid & 7;
      float qn = 0.f;
#pragma unroll
      for (int i = 0; i < 4; ++i) {
        const uint4 q = *(const uint4*)(Qs + l * 264 + part * 32 + i * 8);
        const float4 n0 = *(const float4*)(ns + part * 32 + i * 8), n1 = *(const float4*)(ns + part * 32 + i * 8 + 4);
        qn += lo2f(q.x) * n0.x + hi2f(q.x) * n0.y + lo2f(q.y) * n0.z + hi2f(q.y) * n0.w + lo2f(q.z) * n1.x + hi2f(q.z) * n1.y + lo2f(q.w) * n1.z +
              hi2f(q.w) * n1.w;
      }
      const uint4 pq = *(const uint4*)(Ps + l * 72 + part * 8);
      const float ps = lo2f(pq.x) + hi2f(pq.x) + lo2f(pq.y) + hi2f(pq.y) + lo2f(pq.z) + hi2f(pq.z) + lo2f(pq.w) + hi2f(pq.w);
      float tot = ps + winter_s[l] * qn;
      tot += sx<1>(tot); tot += sx<2>(tot); tot += sx<4>(tot);
      if (part == 0) den_s[l] = tot;
    }
    __syncthreads();
#pragma unroll
    for (int lt = 0; lt < 4; ++lt)
#pragma unroll
      for (int jj = 0; jj < 4; ++jj) {
        const int lr = 16 * lt + 4 * q4 + jj;
        const float d = fmaxf(fabsf(den_s[lr]), emrow_s[lr]);
        hout[(size_t)(t0 + lr) * 1024 + head * 256 + vh * 128 + 16 * wave + n16] = f2bf(iacc[lt][jj] * __builtin_amdgcn_rcpf(d));
      }
    if (tid < 256) {
      float s = 0.f;
#pragma unroll
      for (int i = 0; i < 8; ++i) {
        const uint4 q = *(const uint4*)(KTs + tid * 72 + i * 8);
        const float4 g0 = *(const float4*)(wg_s + i * 8), g1 = *(const float4*)(wg_s + i * 8 + 4);
        s += lo2f(q.x) * g0.x + hi2f(q.x) * g0.y + lo2f(q.y) * g0.z + hi2f(q.y) * g0.w + lo2f(q.z) * g1.x + hi2f(q.z) * g1.y + lo2f(q.w) * g1.z +
             hi2f(q.w) * g1.w;
      }
      nreg = decay * nreg + s;
      ns[tid] = nreg;
    }
    {
      const bf16_t* bp = VTs + (16 * wave + n16) * 72 + 8 * q4;
      const bf16x8 b0 = *(const bf16x8*)(bp), b1 = *(const bf16x8*)(bp + 32);
      const bf16_t* ap = KTs + n16 * 72 + 8 * q4;
#pragma unroll
      for (int kt = 0; kt < 16; ++kt) {
        cst[kt] *= decay;
        cst[kt] = MFMA16(*(const bf16x8*)(ap + kt * 16 * 72), b0, cst[kt]);
        cst[kt] = MFMA16(*(const bf16x8*)(ap + kt * 16 * 72 + 32), b1, cst[kt]);
        if ((kt & 3) == 3) __builtin_amdgcn_sched_barrier(0);
      }
    }
    if (j + 1 < 32) PUT_QK();
    mstate = m_new;
    __syncthreads();
  }
#undef PF_QK
#undef PF_TV
#undef PUT_QK
}

DI void attn_item(const Ctx& c, int item) {
  const int kvg = item & 1, hh = (item >> 1) & 1, qb = (item >> 2) & 15, seq = item >> 6;
  const int tid = c.tid, lane = tid & 63, wave = tid >> 6, r = lane & 31, h = lane >> 5;
  const bf16_t* proj = (const bf16_t*)(c.ws() + OFF_R1);
  bf16_t* ya = (bf16_t*)(c.ws() + OFF_R5);
  bf16_t* Kt = c.lds;
  bf16_t* VTt = Kt + 9216;
  const int head = kvg * 4 + hh * 2 + (wave >> 2), slice = wave & 3;
  const float L2E = 1.4426950408889634f;
  const float nslope2 = -exp2f(-(float)(head + 1)) * L2E, qscale2 = 0.125f * L2E;
  const float sink = c.in(I_SINK)[c.l * 8 + head] * L2E;
  const int q0 = qb * 128 + slice * 32;
  bf16x8 qf[4];
#pragma unroll
  for (int ks = 0; ks < 4; ++ks)
    qf[ks] = *(const bf16x8*)(proj + (size_t)(seq * SEQ + q0 + r) * LDP + P_AQ + head * 64 + ks * 16 + h * 8);
  f32x16 O[2];
#pragma unroll
  for (int e = 0; e < 16; ++e) { O[0][e] = 0.f; O[1][e] = 0.f; }
  float mrun = sink, lsum = 0.f;
  const int kb_lo = (qb == 0) ? 1 : 0, kb_hi = (qb == 15) ? 2 : 3;
  const int kkey = tid >> 3, kdc = (tid & 7) * 8, vkey = tid & 127, vdc = (tid >> 7) * 16;
  const bf16_t* kbase = proj + (size_t)(seq * SEQ + qb * 128 - 128) * LDP + P_AK + kvg * 64;
  const bf16_t* vbase = proj + (size_t)(seq * SEQ + qb * 128 - 128) * LDP + P_AV + kvg * 64;
  uint4 rk0, rk1, rv0, rv1;
  {
    const size_t o = (size_t)kb_lo * 128 * LDP;
    rk0 = *(const uint4*)(kbase + o + (size_t)kkey * LDP + kdc); rk1 = *(const uint4*)(kbase + o + (size_t)(kkey + 64) * LDP + kdc);
    rv0 = *(const uint4*)(vbase + o + (size_t)vkey * LDP + vdc); rv1 = *(const uint4*)(vbase + o + (size_t)vkey * LDP + vdc + 8);
  }
#pragma unroll 1
  for (int kb = kb_lo; kb < kb_hi; ++kb) {
    const int kstart = qb * 128 - 128 + kb * 128;
    *(uint4*)(Kt + kkey * 72 + kdc) = rk0; *(uint4*)(Kt + (kkey + 64) * 72 + kdc) = rk1;
    {
      bf16_t* vd = VTt + vdc * 136 + vkey;
      vd[0 * 136] = (bf16_t)(rv0.x & 0xffff); vd[1 * 136] = (bf16_t)(rv0.x >> 16); vd[2 * 136] = (bf16_t)(rv0.y & 0xffff); vd[3 * 136] = (bf16_t)(rv0.y >> 16);
      vd[4 * 136] = (bf16_t)(rv0.z & 0xffff); vd[5 * 136] = (bf16_t)(rv0.z >> 16); vd[6 * 136] = (bf16_t)(rv0.w & 0xffff); vd[7 * 136] = (bf16_t)(rv0.w >> 16);
      vd[8 * 136] = (bf16_t)(rv1.x & 0xffff); vd[9 * 136] = (bf16_t)(rv1.x >> 16); vd[10 * 136] = (bf16_t)(rv1.y & 0xffff); vd[11 * 136] = (bf16_t)(rv1.y >> 16);
      vd[12 * 136] = (bf16_t)(rv1.z & 0xffff); vd[13 * 136] = (bf16_t)(rv1.z >> 16); vd[14 * 136] = (bf16_t)(rv1.w & 0xffff); vd[15 * 136] = (bf16_t)(rv1.w >> 16);
    }
    __syncthreads();
    if (kb + 1 < kb_hi) {
      const size_t o = (size_t)(kb + 1) * 128 * LDP;
      rk0 = *(const uint4*)(kbase + o + (size_t)kkey * LDP + kdc); rk1 = *(const uint4*)(kbase + o + (size_t)(kkey + 64) * LDP + kdc);
      rv0 = *(const uint4*)(vbase + o + (size_t)vkey * LDP + vdc); rv1 = *(const uint4*)(vbase + o + (size_t)vkey * LDP + vdc + 8);
    }
    f32x16 s[4];
#pragma unroll
    for (int nt = 0; nt < 4; ++nt) {
#pragma unroll
      for (int e = 0; e < 16; ++e) s[nt][e] = 0.f;
#pragma unroll
      for (int ks = 0; ks < 4; ++ks) s[nt] = MFMA(*(const bf16x8*)(Kt + (nt * 32 + r) * 72 + ks * 16 + h * 8), qf[ks], s[nt]);
    }
    const float drel = (float)(kstart - (q0 + r) + 4 * h);
    float mx = -INFINITY;
    if (kstart == qb * 128) {
#pragma unroll
      for (int nt = 0; nt < 4; ++nt)
#pragma unroll
        for (int e = 0; e < 16; ++e) {
          const float d = drel + (float)(nt * 32 + (e & 3) + 8 * (e >> 2));
          const float v = fmaf(nslope2, fabsf(d), s[nt][e] * qscale2);
          s[nt][e] = v; mx = fmaxf(mx, v);
        }
    } else {
#pragma unroll
      for (int nt = 0; nt < 4; ++nt)
#pragma unroll
        for (int e = 0; e < 16; ++e) {
          const float d = drel + (float)(nt * 32 + (e & 3) + 8 * (e >> 2));
          const float v = (fabsf(d) <= 128.f) ? fmaf(nslope2, fabsf(d), s[nt][e] * qscale2) : -INFINITY;
          s[nt][e] = v; mx = fmaxf(mx, v);
        }
    }
    mx = fmaxf(mx, bperm(lane ^ 32, mx));
    const float mn = fmaxf(mrun, mx);
    const float alpha = __builtin_amdgcn_exp2f(mrun - mn);
    mrun = mn;
    float ls = 0.f;
#pragma unroll
    for (int nt = 0; nt < 4; ++nt)
#pragma unroll
      for (int e = 0; e < 16; ++e) { const float pv = __builtin_amdgcn_exp2f(s[nt][e] - mn); s[nt][e] = pv; ls += pv; }
    lsum = lsum * alpha + ls;
#pragma unroll
    for (int e = 0; e < 16; ++e) { O[0][e] *= alpha; O[1][e] *= alpha; }
#pragma unroll
    for (int nt = 0; nt < 4; ++nt)
#pragma unroll
      for (int s2 = 0; s2 < 2; ++s2) {
        uint4 pu;
        pu.x = pack2(s[nt][8 * s2], s[nt][8 * s2 + 1]); pu.y = pack2(s[nt][8 * s2 + 2], s[nt][8 * s2 + 3]);
        pu.z = pack2(s[nt][8 * s2 + 4], s[nt][8 * s2 + 5]); pu.w = pack2(s[nt][8 * s2 + 6], s[nt][8 * s2 + 7]);
        const bf16x8 pfrag = __builtin_bit_cast(bf16x8, pu);
        const bf16_t* vp = VTt + r * 136 + nt * 32 + 16 * s2 + 4 * h;
        O[0] = MFMA(frag_from(*(const uint2*)vp, *(const uint2*)(vp + 8)), pfrag, O[0]);
        O[1] = MFMA(frag_from(*(const uint2*)(vp + 32 * 136), *(const uint2*)(vp + 32 * 136 + 8)), pfrag, O[1]);
      }
    __syncthreads();
  }
  float l = lsum + bperm(lane ^ 32, lsum);
  l += __builtin_amdgcn_exp2f(sink - mrun);
  const float inv = 1.f / l;
  bf16_t* op = ya + (size_t)(seq * SEQ + q0 + r) * 1024 + head * 64 + 4 * h;
#pragma unroll
  for (int dt = 0; dt < 2; ++dt)
#pragma unroll
    for (int g = 0; g < 4; ++g) {
      uint2 o; o.x = pack2(O[dt][4 * g] * inv, O[dt][4 * g + 1] * inv); o.y = pack2(O[dt][4 * g + 2] * inv, O[dt][4 * g + 3] * inv);
      *(uint2*)(op + dt * 32 + 8 * g) = o;
    }
}

DI void sgu_item(const Ctx& c, int item) {
  const int chunk = item & 15, seq = item >> 4;
  const int tid = c.tid, lane = tid & 63, wave = tid >> 6, r = lane & 31, h = lane >> 5;
  const bf16_t* proj = (const bf16_t*)(c.ws() + OFF_R1);
  bf16_t* yc = (bf16_t*)(c.ws() + OFF_R5) + 512;
  bf16_t* wsb = c.lds;
  bf16_t* vnT = wsb + 128 * 136;
  float* mean_s = (float*)(vnT + 128 * 136); float* rstd_s = mean_s + 128;
  const int t0 = seq * SEQ + chunk * 128;
  const float* lnw = c.in(I_CLNW) + (size_t)c.l * 512;
  const float* lnb = c.in(I_CLNB) + (size_t)c.l * 512;
  {
    const int tok = tid >> 2, part = tid & 3;
    float s = 0.f, q = 0.f;
#pragma unroll
    for (int i = 0; i < 16; ++i) {
      const uint4 v = *(const uint4*)(proj + (size_t)(t0 + tok) * LDP + P_V + part * 128 + i * 8);
      const float f[8] = {lo2f(v.x), hi2f(v.x), lo2f(v.y), hi2f(v.y), lo2f(v.z), hi2f(v.z), lo2f(v.w), hi2f(v.w)};
#pragma unroll
      for (int jj = 0; jj < 8; ++jj) { s += f[jj]; q += f[jj] * f[jj]; }
    }
    s += sx<1>(s); s += sx<2>(s); q += sx<1>(q); q += sx<2>(q);
    const float mean = s * (1.f / 512.f);
    const float var = fmaxf(q * (1.f / 512.f) - mean * mean, 0.f);
    if (part == 0) { mean_s[tok] = mean; rstd_s[tok] = rsqrtf(var + LN_EPS); }
  }
  __syncthreads();
  const int ct = wave >> 1, tt0 = (wave & 1) * 2;
  const int ws_t = tid >> 5, ws_q = (tid & 31) * 4;
  const int vs_s = tid & 127, vs_c = (tid >> 7) * 8;
  float4 rw[8]; uint4 rv[4];
#define SGU_PREFETCH(g_) do { const float* wsg_ = c.in(I_CWS) + ((size_t)(c.l * 4 + (g_))) * 16384; \
    _Pragma("unroll") for (int i = 0; i < 8; ++i) rw[i] = *(const float4*)(wsg_ + (ws_t + 16 * i) * 128 + ws_q); \
    _Pragma("unroll") for (int i = 0; i < 4; ++i) rv[i] = *(const uint4*)(proj + (size_t)(t0 + vs_s) * LDP + P_V + (g_) * 128 + vs_c + 32 * i); } while (0)
  SGU_PREFETCH(0);
#pragma unroll 1
  for (int gq = 0; gq < 4; ++gq) {
#pragma unroll
    for (int i = 0; i < 8; ++i) { uint2 o; o.x = pack2(rw[i].x, rw[i].y); o.y = pack2(rw[i].z, rw[i].w); *(uint2*)(wsb + (ws_t + 16 * i) * 136 + ws_q) = o; }
    {
      const float mean = mean_s[vs_s], rstd = rstd_s[vs_s];
#pragma unroll
      for (int i = 0; i < 4; ++i) {
        const int cc = vs_c + 32 * i;
        const uint4 v = rv[i];
        const float4 w0 = *(const float4*)(lnw + gq * 128 + cc), w1 = *(const float4*)(lnw + gq * 128 + cc + 4);
        const float4 b0 = *(const float4*)(lnb + gq * 128 + cc), b1 = *(const float4*)(lnb + gq * 128 + cc + 4);
        bf16_t* d = vnT + cc * 136 + vs_s;
        d[0 * 136] = f2bf((lo2f(v.x) - mean) * rstd * w0.x + b0.x); d[1 * 136] = f2bf((hi2f(v.x) - mean) * rstd * w0.y + b0.y);
        d[2 * 136] = f2bf((lo2f(v.y) - mean) * rstd * w0.z + b0.z); d[3 * 136] = f2bf((hi2f(v.y) - mean) * rstd * w0.w + b0.w);
        d[4 * 136] = f2bf((lo2f(v.z) - mean) * rstd * w1.x + b1.x); d[5 * 136] = f2bf((hi2f(v.z) - mean) * rstd * w1.y + b1.y);
        d[6 * 136] = f2bf((lo2f(v.w) - mean) * rstd * w1.z + b1.z); d[7 * 136] = f2bf((hi2f(v.w) - mean) * rstd * w1.w + b1.w);
      }
    }
    __syncthreads();
    if (gq < 3) SGU_PREFETCH(gq + 1);
    uint2 u[2][4];
    const float* bs = c.in(I_CBS) + ((size_t)(c.l * 4 + gq)) * 128;
    float bb[2];
#pragma unroll
    for (int i = 0; i < 2; ++i) {
      const int t = (tt0 + i) * 32 + r;
      bb[i] = bs[t];
      const bf16_t* up = proj + (size_t)(t0 + t) * LDP + P_U + gq * 128 + ct * 32 + 4 * h;
#pragma unroll
      for (int g = 0; g < 4; ++g) u[i][g] = *(const uint2*)(up + 8 * g);
    }
    f32x16 acc[2];
#pragma unroll
    for (int e = 0; e < 16; ++e) { acc[0][e] = 0.f; acc[1][e] = 0.f; }
#pragma unroll
    for (int ks = 0; ks < 8; ++ks) {
      const bf16x8 a = *(const bf16x8*)(vnT + (ct * 32 + r) * 136 + ks * 16 + h * 8);
      acc[0] = MFMA(a, *(const bf16x8*)(wsb + (tt0 * 32 + r) * 136 + ks * 16 + h * 8), acc[0]);
      acc[1] = MFMA(a, *(const bf16x8*)(wsb + (tt0 * 32 + 32 + r) * 136 + ks * 16 + h * 8), acc[1]);
    }
#pragma unroll
    for (int i = 0; i < 2; ++i) {
      const int t = (tt0 + i) * 32 + r;
      bf16_t* op = yc + (size_t)(t0 + t) * 1024 + gq * 128 + ct * 32 + 4 * h;
#pragma unroll
      for (int g = 0; g < 4; ++g) {
        uint2 o;
        o.x = pack2(lo2f(u[i][g].x) * (acc[i][4 * g] + bb[i]), hi2f(u[i][g].x) * (acc[i][4 * g + 1] + bb[i]));
        o.y = pack2(lo2f(u[i][g].y) * (acc[i][4 * g + 2] + bb[i]), hi2f(u[i][g].y) * (acc[i][4 * g + 3] + bb[i]));
        *(uint2*)(op + 8 * g) = o;
      }
    }
    __syncthreads();
  }
#undef SGU_PREFETCH
}

DI void phase_mix(const Ctx& c) {
  constexpr int N_SCAN = GSEQ * 16, N_ATT = GSEQ * 64, N_SGU = GSEQ * 16;
  for (int it = c.bid; it < N_SCAN + N_ATT + N_SGU; it += c.nb) {
    Ctx c2 = c;
    asm volatile("" : "+v"(c2.tid));
    asm volatile("" : "+s"(c2.wsp));
    if (it < N_SCAN) {
      const int sa = it >> 3, sx = it & 7;
      scan_item(c2, ((sx + 8 * (sa >> 1)) << 1) | (sa & 1));
#if REPEAT_SCAN
      __syncthreads(); asm volatile("" : "+v"(c2.tid)); scan_item(c2, ((sx + 8 * (sa >> 1)) << 1) | (sa & 1));
#endif
    }
    else if (it < N_SCAN + N_ATT) { attn_item(c2, it - N_SCAN);
#if REPEAT_ATT
      __syncthreads(); asm volatile("" : "+v"(c2.tid)); attn_item(c2, it - N_SCAN);
#endif
    }
    else sgu_item(c2, it - N_SCAN - N_ATT);
    __syncthreads();
  }
}

#define XB_TMO      128
#define XB_XCNT(j)  (256  + 64 * (j))
#define XB_XSUB(j)  (1280 + 64 * (j))
#define XB_XGEN(j)  (2304 + 64 * (j))
#define XB_TOP      3328
#define XB_TOPGEN   3392
#define XCD_BAR_WORDS 3456
#define XB_SPIN_CAP (1u << 18)
DI unsigned xb_ld(unsigned* p) { return __hip_atomic_load(p, __ATOMIC_RELAXED, __HIP_MEMORY_SCOPE_AGENT); }
DI unsigned xb_add(unsigned* p, unsigned v) { return __hip_atomic_fetch_add(p, v, __ATOMIC_RELAXED, __HIP_MEMORY_SCOPE_AGENT); }
DI unsigned xb_xcc_id() { return (unsigned)__builtin_amdgcn_s_getreg((3 << 11) | 20) & 0xFu; }
#define XB_SPIN(cond, bar) do { unsigned _sp = 0; while (cond) { __builtin_amdgcn_s_sleep(1); \
    if ((++_sp & 255u) == 0u) { if (xb_ld(&(bar)[XB_TMO])) break; if (_sp > XB_SPIN_CAP) { atomicAdd(&(bar)[XB_TMO], 1u); break; } } } } while (0)
struct XcdBarrier { unsigned* bar; unsigned x; volatile LAS unsigned* st; };
DI XcdBarrier xcd_barrier_post(unsigned* bar, volatile LAS unsigned* st) {
  XcdBarrier b; b.bar = bar; b.x = xb_xcc_id(); b.st = st;
  if (threadIdx.x == 0) (void)xb_add(&bar[XB_XCNT(b.x)], 1u);
  return b;
}
DI void xcd_barrier_complete(unsigned* bar, unsigned x, unsigned& nloc, unsigned& nx) {
  const unsigned G = gridDim.x * gridDim.y * gridDim.z;
  unsigned sum, cnt, mine, sp = 0u;
  for (;;) {
    sum = 0u; cnt = 0u; mine = 0u;
#pragma unroll
    for (unsigned j = 0; j < 16; ++j) { const unsigned c = xb_ld(&bar[XB_XCNT(j)]); sum += c; cnt += (c > 0u) ? 1u : 0u; mine = (j == x) ? c : mine; }
    if (sum == G) break;
    __builtin_amdgcn_s_sleep(1);
    if ((++sp & 255u) == 0u) { if (xb_ld(&bar[XB_TMO])) break; if (sp > XB_SPIN_CAP) { atomicAdd(&bar[XB_TMO], 1u); break; } }
  }
  nloc = mine > 0u ? mine : 1u; nx = cnt > 0u ? cnt : 1u;
}
DI void xcd_barrier(const XcdBarrier& b) {
  asm volatile("s_waitcnt vmcnt(0)" ::: "memory");
  __syncthreads();
  if (threadIdx.x == 0) {
    unsigned* bar = b.bar;
    __builtin_amdgcn_s_waitcnt(0);
    unsigned nloc = b.st[0], nx = b.st[1];
    if (nloc == 0u) { xcd_barrier_complete(bar, b.x, nloc, nx); b.st[0] = nloc; b.st[1] = nx; }
    const unsigned old = xb_add(&bar[XB_XSUB(b.x)], 1u);
    const unsigned gen = old / nloc;
    if (old + 1u == (gen + 1u) * nloc) {
      __builtin_amdgcn_fence(__ATOMIC_RELEASE, "agent");
      asm volatile("s_waitcnt vmcnt(0)" ::: "memory");
      const unsigned og = xb_add(&bar[XB_TOP], 1u);
      const unsigned tg = og / nx;
      if (og + 1u == (tg + 1u) * nx) xb_add(&bar[XB_TOPGEN], 1u);
      else XB_SPIN(xb_ld(&bar[XB_TOPGEN]) == tg, bar);
      __builtin_amdgcn_fence(__ATOMIC_ACQUIRE, "agent");
      xb_add(&bar[XB_XGEN(b.x)], 1u);
      asm volatile("s_waitcnt vmcnt(0)" ::: "memory");
    } else {
      XB_SPIN(xb_ld(&bar[XB_XGEN(b.x)]) == gen, bar);
      __builtin_amdgcn_fence(__ATOMIC_ACQUIRE, "agent");
      asm volatile("s_waitcnt vmcnt(0)" ::: "memory");
    }
  }
  __syncthreads();
}

constexpr int STEPS_PER_LAYER = 11, STEPS_PER_GROUP = 1 + DEPTH * STEPS_PER_LAYER, N_STEPS = 1 + NGROUP * STEPS_PER_GROUP;

DI void run_step(const Params& P, int step, bf16_t* lds) {
  int tid = threadIdx.x, bid = blockIdx.x, nb = gridDim.x;
  unsigned char* wsp = P.ws;
  asm volatile("" : "+v"(tid));
  asm volatile("" : "+s"(bid), "+s"(nb), "+s"(wsp));
  if (step == 0) {
    for (int it = bid; it < PREP_ITEMS; it += nb) prep_item(P, it, lds, tid);
    return;
  }
  step -= 1;
  Ctx c; c.p = &P; c.lds = lds; c.tid = tid; c.bid = bid; c.nb = nb; c.wsp = wsp;
  c.g = step / STEPS_PER_GROUP; int s = step - c.g * STEPS_PER_GROUP;
  if (s == 0) { c.l = 0; phase_xm0(c); return; }
  s -= 1; c.l = s / STEPS_PER_LAYER; s -= c.l * STEPS_PER_LAYER;
  const int l = c.l;
  switch (s) {
    case 0: phase_g1(c); break;
    case 1: phase_conv(c); gate_prepass(c); break;
    case 2: phase_g2(c); break;
    case 3: phase_mix(c); break;
    case 4: phase_post(c); break;
    case 5: phase_merge(c); break;
    case 6: phase_wout(c); break;
    case 7: phase_ln<true>(c, (const bf16_t*)(wsp + OFF_R3 + 64 * MiB), c.xin(), c.in(I_LN1W) + l * 1024, c.in(I_LN1B) + l * 1024, l, 3, 4); break;
    case 8: phase_mlp1(c); break;
    case 9: phase_mlp2(c); break;
    case 10: phase_ln<false>(c, (const bf16_t*)(wsp + OFF_R1 + 256 * MiB), c.xout(), c.in(I_LN2W) + l * 1024, c.in(I_LN2B) + l * 1024, (l + 1 < DEPTH) ? l + 1 : -1, 0, 1); break;
  }
}

__global__ void __launch_bounds__(NT) fwd_megakernel(Params P) {
  extern __shared__ __attribute__((aligned(16))) unsigned char smem[];
  bf16_t* lds = (bf16_t*)smem;
  cg::grid_group grid = cg::this_grid();
  volatile LAS unsigned* xst = (volatile LAS unsigned*)(LAS unsigned char*)(smem + LDS_WORK);
  if (threadIdx.x < 4) xst[threadIdx.x] = 0u;
  __syncthreads();
  const XcdBarrier xb = xcd_barrier_post((unsigned*)(P.ws + OFF_BAR), xst);
  for (int s = P.step_lo; s < P.step_hi; ++s) {
    run_step(P, s, lds);
#if REPEAT_MASK
    {
      int rs = -1;
      if (s == 0) rs = 12; else { int q = (s - 1) % STEPS_PER_GROUP; rs = (q == 0) ? 11 : (q - 1) % STEPS_PER_LAYER; }
      if ((REPEAT_MASK >> rs) & 1) { grid.sync(); run_step(P, s, lds); }
    }
#endif
#if EXTRA_SYNC
    grid.sync();
#endif
    if (s + 1 < P.step_hi) { if (s == 0) grid.sync(); else xcd_barrier(xb); }
  }
}

extern "C" void kernel_launch(void* const* d_in, const int* in_sizes, int n_in, void* d_out, int out_size, void* d_ws, size_t ws_size,
                              hipStream_t stream) {
  static int grid_blocks = 0;
  if (!grid_blocks) {
    int dev = 0, cus = 0, per_cu = 0;
    hipGetDevice(&dev);
    hipDeviceGetAttribute(&cus, hipDeviceAttributeMultiprocessorCount, dev);
    hipFuncSetAttribute((const void*)fwd_megakernel, hipFuncAttributeMaxDynamicSharedMemorySize, LDS_BYTES);
    hipOccupancyMaxActiveBlocksPerMultiprocessor(&per_cu, (const void*)fwd_megakernel, NT, LDS_BYTES);
    if (per_cu < 1) per_cu = 1;
    grid_blocks = cus * per_cu;
    if (ws_size < WS_END) fprintf(stderr, "workspace too small: %zu < %zu\n", ws_size, (size_t)WS_END);
  }
  Params p{};
  for (int i = 0; i < 31; ++i) p.in[i] = (const float*)d_in[i];
  p.out = (float*)d_out; p.ws = (unsigned char*)d_ws;
#if MULTI_LAUNCH
  for (int s = 0; s < N_STEPS; ++s) {
    p.step_lo = s; p.step_hi = s + 1;
    hipLaunchKernelGGL(fwd_megakernel, dim3(grid_blocks), dim3(NT), LDS_BYTES, stream, p);
  }
#else
  p.step_lo = 0; p.step_hi = N_STEPS;
  (void)hipMemsetAsync((char*)d_ws + OFF_BAR, 0, XCD_BAR_WORDS * sizeof(unsigned), stream);
  void* args[] = {&p};
  hipError_t e = hipLaunchCooperativeKernel((const void*)fwd_megakernel, dim3(grid_blocks), dim3(NT), args, LDS_BYTES, stream);
  if (e != hipSuccess) fprintf(stderr, "cooperative launch failed: %s (grid %d)\n", hipGetErrorString(e), grid_blocks);
#endif
}
```
